# Optimizing an MI355X kernel written in HIP

```python
import math
import jax, jax.numpy as jnp
from jax import lax
import numpy as np

D_MODEL = 1024
BATCH = 8
SEQ = 4096
DEPTH = 2

GROUP_WIDTH = D_MODEL // 4
D_MIX = 4 * GROUP_WIDTH
EPS = 1e-6

GLA_HEADS = 4
GLA_DK = GROUP_WIDTH // (2 * GLA_HEADS)
GLA_DV = GROUP_WIDTH // GLA_HEADS
GLA_GATE_RANK = 16
GLA_GATE_NORM = 16.0
GLA_CHUNK = 64

DIFF_HEADS = 4
DIFF_DH = GROUP_WIDTH // (2 * DIFF_HEADS)
DIFF_DV = 2 * DIFF_DH
DIFF_BLOCK = 128
ROPE_THETA = 10000.0

S5_CH = 16
S5_GROUPS = GROUP_WIDTH // S5_CH
S5_STATE = 64

LRU_WIDTH = GROUP_WIDTH
LRU_BLOCKS = 4
LRU_BLOCK = LRU_WIDTH // LRU_BLOCKS
LRU_CONV = 4
LRU_C = 8.0

D_FF = 4 * D_MODEL

SPLITS = (GLA_HEADS * GLA_DK, GLA_HEADS * GLA_DK, GLA_HEADS * GLA_DV, GLA_GATE_RANK, GLA_HEADS * GLA_DV,
          DIFF_HEADS * 2 * DIFF_DH, DIFF_HEADS * 2 * DIFF_DH, DIFF_HEADS * DIFF_DV,
          GROUP_WIDTH,
          LRU_WIDTH, LRU_WIDTH)
D_IN = sum(SPLITS)

kernel_name = "hybrid_parallel_gla_diff_s5_rglru"


def _rmsnorm(x, g):
    xf = x.astype(jnp.float32)
    y = xf * lax.rsqrt(jnp.mean(xf * xf, axis=-1, keepdims=True) + EPS) * g.astype(jnp.float32)
    return y.astype(x.dtype)


def _split_cols(p):
    offs = [int(o) for o in np.cumsum(SPLITS)[:-1]]
    return jnp.split(p, offs, axis=-1)


def _lin_combine(e1, e2):
    a1, b1 = e1
    a2, b2 = e2
    return (a2 * a1, a2 * b1 + b2)


def _gla(q, k, v, glr, og, w_gate, b_gate, norm_g):
    f32 = jnp.float32
    B, S, _ = q.shape
    H, DK, DV, C = GLA_HEADS, GLA_DK, GLA_DV, GLA_CHUNK
    NC = S // C

    def chunks(t, d):
        return t.astype(f32).reshape(B, NC, C, H, d).transpose(0, 3, 1, 2, 4)

    qc = chunks(q, DK) * (DK ** -0.5)
    kc = chunks(k, DK)
    vc = chunks(v, DV)
    g = jax.nn.log_sigmoid(glr.astype(f32) @ w_gate.astype(f32) + b_gate.astype(f32)) / GLA_GATE_NORM
    gc = g.reshape(B, NC, C, H, DK).transpose(0, 3, 1, 2, 4)
    bcum = jnp.cumsum(gc, axis=3)
    blast = bcum[:, :, :, -1:, :]
    q_dec = qc * jnp.exp(bcum)
    k_dec = kc * jnp.exp(-bcum)
    k_st = kc * jnp.exp(blast - bcum)
    mask = jnp.tril(jnp.ones((C, C), dtype=bool))
    attn = jnp.where(mask, jnp.einsum('bhncd,bhnjd->bhncj', q_dec, k_dec), 0.0)
    o = jnp.einsum('bhncj,bhnjv->bhncv', attn, vc)
    kv = jnp.einsum('bhncd,bhncv->bhndv', k_st, vc)
    dec = jnp.exp(blast[:, :, :, 0, :])

    def step(state, inp):
        d, kvn = inp
        return d[..., None] * state + kvn, state

    _, s_prev = lax.scan(step, jnp.zeros((B, H, DK, DV), f32),
                         (jnp.moveaxis(dec, 2, 0), jnp.moveaxis(kv, 2, 0)))
    s_prev = jnp.moveaxis(s_prev, 0, 2)
    o = o + jnp.einsum('bhncd,bhndv->bhncv', q_dec, s_prev)
    o = o.transpose(0, 2, 3, 1, 4).reshape(B, S, H, DV)
    o = _rmsnorm(o, norm_g) * jax.nn.silu(og.astype(f32).reshape(B, S, H, DV))
    return o.reshape(B, S, H * DV)


def _rope_tables(S, dh):
    inv = ROPE_THETA ** (-jnp.arange(0, dh, 2, dtype=jnp.float32) / dh)
    ang = jnp.arange(S, dtype=jnp.float32)[:, None] * inv[None, :]
    emb = jnp.concatenate([ang, ang], axis=-1)
    return jnp.cos(emb), jnp.sin(emb)


def _rope(x, cos, sin):
    c = cos[None, :, None, None, :].astype(x.dtype)
    s = sin[None, :, None, None, :].astype(x.dtype)
    x1, x2 = jnp.split(x, 2, axis=-1)
    return x * c + jnp.concatenate([-x2, x1], axis=-1) * s


def _diff_attn(q, k, v, lq1, lk1, lq2, lk2, norm_g, lam_init):
    f32 = jnp.float32
    B, S, _ = q.shape
    H, DH, DV, BLK = DIFF_HEADS, DIFF_DH, DIFF_DV, DIFF_BLOCK
    NB = S // BLK
    cos, sin = _rope_tables(S, DH)
    q = _rope(q.reshape(B, S, H, 2, DH), cos, sin) * (DH ** -0.5)
    k = _rope(k.reshape(B, S, H, 2, DH), cos, sin)
    v = v.reshape(B, S, H, DV)
    lam = (jnp.exp(jnp.sum(lq1.astype(f32) * lk1.astype(f32)))
           - jnp.exp(jnp.sum(lq2.astype(f32) * lk2.astype(f32))) + lam_init)
    qb = q.reshape(B, NB, BLK, H, 2, DH).transpose(1, 0, 2, 3, 4, 5)
    kpos = jnp.arange(S)

    def block(args):
        q_blk, i = args
        s = jnp.einsum('bqhcd,bkhcd->bhcqk', q_blk, k).astype(f32)
        qpos = i * BLK + jnp.arange(BLK)
        mask = kpos[None, :] <= qpos[:, None]
        p = jax.nn.softmax(jnp.where(mask, s, -jnp.inf), axis=-1)
        w = p[:, :, 0] - lam * p[:, :, 1]
        return jnp.einsum('bhqk,bkhv->bqhv', w.astype(v.dtype), v)

    o = lax.map(block, (qb, jnp.arange(NB)))
    o = o.transpose(1, 0, 2, 3, 4).reshape(B, S, H, DV)
    o = _rmsnorm(o, norm_g) * (1.0 - lam_init)
    return o.reshape(B, S, H * DV)


def _s5(u, log_step, a_re, a_im, b_re, b_im, c_re, c_im, d, w_glu, b_glu):
    f32 = jnp.float32
    B, S, W = u.shape
    G, P, CH = S5_GROUPS, S5_STATE, S5_CH
    uf = u.astype(f32)
    ug = uf.reshape(B, S, G, CH)
    step = jnp.exp(log_step.astype(f32))[:, None]
    lr, li = a_re.astype(f32), a_im.astype(f32)
    mag = jnp.exp(lr * step)
    ab_re = mag * jnp.cos(li * step)
    ab_im = mag * jnp.sin(li * step)
    den = lr * lr + li * li
    nr, ni = ab_re - 1.0, ab_im
    cr = (nr * lr + ni * li) / den
    ci = (ni * lr - nr * li) / den
    br, bi = b_re.astype(f32), b_im.astype(f32)
    bb_re = cr[..., None] * br - ci[..., None] * bi
    bb_im = cr[..., None] * bi + ci[..., None] * br
    bu_re = jnp.einsum('bsgh,gph->bsgp', ug, bb_re)
    bu_im = jnp.einsum('bsgh,gph->bsgp', ug, bb_im)
    ar = jnp.broadcast_to(ab_re[None, None], (1, S, G, P))
    ai = jnp.broadcast_to(ab_im[None, None], (1, S, G, P))

    def combine(e1, e2):
        a1r, a1i, b1r, b1i = e1
        a2r, a2i, b2r, b2i = e2
        return (a2r * a1r - a2i * a1i, a2r * a1i + a2i * a1r,
                a2r * b1r - a2i * b1i + b2r, a2r * b1i + a2i * b1r + b2i)

    _, _, xr, xi = lax.associative_scan(combine, (ar, ai, bu_re, bu_im), axis=1)
    y = (jnp.einsum('gqp,bsgp->bsgq', c_re.astype(f32), xr)
         - jnp.einsum('gqp,bsgp->bsgq', c_im.astype(f32), xi))
    y = y.reshape(B, S, W) + d.astype(f32) * uf
    y = jax.nn.gelu(y)
    return y * jax.nn.sigmoid(y @ w_glu.astype(f32) + b_glu.astype(f32))


def _rglru(xb, gate, conv_w, conv_b, w_a, b_a, w_x, b_x, lam):
    f32 = jnp.float32
    B, S, W = xb.shape
    xc = lax.conv_general_dilated(xb.astype(f32), conv_w.astype(f32)[:, None, :],
                                  window_strides=(1,), padding=[(LRU_CONV - 1, 0)],
                                  dimension_numbers=('NWC', 'WIO', 'NWC'),
                                  feature_group_count=W) + conv_b.astype(f32)
    xr = xc.reshape(B, S, LRU_BLOCKS, LRU_BLOCK)
    r = jax.nn.sigmoid(jnp.einsum('bsnc,ncd->bsnd', xr, w_a.astype(f32)).reshape(B, S, W) + b_a.astype(f32))
    i = jax.nn.sigmoid(jnp.einsum('bsnc,ncd->bsnd', xr, w_x.astype(f32)).reshape(B, S, W) + b_x.astype(f32))
    log_a = -LRU_C * r * jax.nn.softplus(-lam.astype(f32))
    a = jnp.exp(log_a)
    mult = jnp.sqrt(jnp.maximum(-jnp.expm1(2.0 * log_a), 1e-12))
    _, h = lax.associative_scan(_lin_combine, (a, mult * (i * xc)), axis=1)
    return h * jax.nn.gelu(gate.astype(f32))


def setup_inputs(seed: int = 0) -> dict:
    key = jax.random.key(seed)
    ks = iter(jax.random.split(key, 48))
    f32 = jnp.float32
    L = DEPTH

    def nrm(shape, scale):
        return jax.random.normal(next(ks), shape, f32) * scale

    def gain(shape):
        return 1.0 + 0.01 * jax.random.normal(next(ks), shape, f32)

    x = nrm((BATCH, SEQ, D_MODEL), 1.0)
    ln_mix_pre = gain((L, D_MODEL))
    ln_mix_post = gain((L, D_MODEL))
    ln_ffn_pre = gain((L, D_MODEL))
    ln_ffn_post = gain((L, D_MODEL))
    w_in = nrm((L, D_MODEL, D_IN), D_MODEL ** -0.5)
    w_out = nrm((L, D_MIX, D_MODEL), D_MIX ** -0.5)
    gla_w_gate = nrm((L, GLA_GATE_RANK, GLA_HEADS * GLA_DK), GLA_GATE_RANK ** -0.5)
    gla_b_gate = nrm((L, GLA_HEADS * GLA_DK), 0.01)
    gla_norm = gain((L, GLA_DV))
    diff_lq1 = nrm((L, DIFF_DH), 0.1)
    diff_lk1 = nrm((L, DIFF_DH), 0.1)
    diff_lq2 = nrm((L, DIFF_DH), 0.1)
    diff_lk2 = nrm((L, DIFF_DH), 0.1)
    diff_norm = gain((L, DIFF_DV))
    s5_log_step = jax.random.uniform(next(ks), (L, S5_GROUPS), f32,
                                     minval=math.log(1e-3), maxval=math.log(1e-1))
    s5_a_re = -0.5 + nrm((L, S5_GROUPS, S5_STATE), 0.01)
    s5_a_im = math.pi * jnp.arange(S5_STATE, dtype=f32)[None, None, :] + nrm((L, S5_GROUPS, S5_STATE), 0.01)
    s5_b_re = nrm((L, S5_GROUPS, S5_STATE, S5_CH), (2 * S5_CH) ** -0.5)
    s5_b_im = nrm((L, S5_GROUPS, S5_STATE, S5_CH), (2 * S5_CH) ** -0.5)
    s5_c_re = nrm((L, S5_GROUPS, S5_CH, S5_STATE), (2 * S5_STATE) ** -0.5)
    s5_c_im = nrm((L, S5_GROUPS, S5_CH, S5_STATE), (2 * S5_STATE) ** -0.5)
    s5_d = nrm((L, GROUP_WIDTH), 1.0)
    s5_w_glu = nrm((L, GROUP_WIDTH, GROUP_WIDTH), GROUP_WIDTH ** -0.5)
    s5_b_glu = nrm((L, GROUP_WIDTH), 0.01)
    lru_conv_w = nrm((L, LRU_CONV, LRU_WIDTH), LRU_CONV ** -0.5)
    lru_conv_b = nrm((L, LRU_WIDTH), 0.01)
    lru_w_a = nrm((L, LRU_BLOCKS, LRU_BLOCK, LRU_BLOCK), LRU_BLOCK ** -0.5)
    lru_b_a = nrm((L, LRU_WIDTH), 0.01)
    lru_w_x = nrm((L, LRU_BLOCKS, LRU_BLOCK, LRU_BLOCK), LRU_BLOCK ** -0.5)
    lru_b_x = nrm((L, LRU_WIDTH), 0.01)
    a_pow = jax.random.uniform(next(ks), (L, LRU_WIDTH), f32, minval=0.9, maxval=0.999)
    a0 = a_pow ** (1.0 / LRU_C)
    lru_lambda = jnp.log(a0) - jnp.log1p(-a0)
    ffn_w1 = nrm((L, D_MODEL, D_FF), D_MODEL ** -0.5)
    ffn_w2 = nrm((L, D_FF, D_MODEL), D_FF ** -0.5)
    return {"x": x, "ln_mix_pre": ln_mix_pre, "ln_mix_post": ln_mix_post,
            "ln_ffn_pre": ln_ffn_pre, "ln_ffn_post": ln_ffn_post,
            "w_in": w_in, "w_out": w_out,
            "gla_w_gate": gla_w_gate, "gla_b_gate": gla_b_gate, "gla_norm": gla_norm,
            "diff_lq1": diff_lq1, "diff_lk1": diff_lk1, "diff_lq2": diff_lq2, "diff_lk2": diff_lk2,
            "diff_norm": diff_norm,
            "s5_log_step": s5_log_step, "s5_a_re": s5_a_re, "s5_a_im": s5_a_im,
            "s5_b_re": s5_b_re, "s5_b_im": s5_b_im, "s5_c_re": s5_c_re, "s5_c_im": s5_c_im,
            "s5_d": s5_d, "s5_w_glu": s5_w_glu, "s5_b_glu": s5_b_glu,
            "lru_conv_w": lru_conv_w, "lru_conv_b": lru_conv_b, "lru_w_a": lru_w_a, "lru_b_a": lru_b_a,
            "lru_w_x": lru_w_x, "lru_b_x": lru_b_x, "lru_lambda": lru_lambda,
            "ffn_w1": ffn_w1, "ffn_w2": ffn_w2}


def reference(x, ln_mix_pre, ln_mix_post, ln_ffn_pre, ln_ffn_post, w_in, w_out,
              gla_w_gate, gla_b_gate, gla_norm,
              diff_lq1, diff_lk1, diff_lq2, diff_lk2, diff_norm,
              s5_log_step, s5_a_re, s5_a_im, s5_b_re, s5_b_im, s5_c_re, s5_c_im,
              s5_d, s5_w_glu, s5_b_glu,
              lru_conv_w, lru_conv_b, lru_w_a, lru_b_a, lru_w_x, lru_b_x, lru_lambda,
              ffn_w1, ffn_w2):
    for l in range(DEPTH):
        lam_init = 0.8 - 0.6 * math.exp(-0.3 * l)
        h = _rmsnorm(x, ln_mix_pre[l])
        proj = h @ w_in[l]
        (g_q, g_k, g_v, g_lr, g_og, d_q, d_k, d_v, s_u, r_x, r_g) = _split_cols(proj)
        o_a = _gla(g_q, g_k, g_v, g_lr, g_og, gla_w_gate[l], gla_b_gate[l], gla_norm[l])
        o_b = _diff_attn(d_q, d_k, d_v, diff_lq1[l], diff_lk1[l], diff_lq2[l], diff_lk2[l],
                         diff_norm[l], lam_init)
        o_c = _s5(s_u, s5_log_step[l], s5_a_re[l], s5_a_im[l], s5_b_re[l], s5_b_im[l],
                  s5_c_re[l], s5_c_im[l], s5_d[l], s5_w_glu[l], s5_b_glu[l])
        o_d = _rglru(r_x, r_g, lru_conv_w[l], lru_conv_b[l], lru_w_a[l], lru_b_a[l],
                     lru_w_x[l], lru_b_x[l], lru_lambda[l])
        mix = jnp.concatenate([o_a.astype(x.dtype), o_b.astype(x.dtype),
                               o_c.astype(x.dtype), o_d.astype(x.dtype)], axis=-1) @ w_out[l]
        x = x + _rmsnorm(mix, ln_mix_post[l])
        h = _rmsnorm(x, ln_ffn_pre[l])
        f = jnp.square(jax.nn.relu(h @ ffn_w1[l])) @ ffn_w2[l]
        x = x + _rmsnorm(f, ln_ffn_post[l])
    return x
```

```cpp
#include <hip/hip_runtime.h>
#include <hip/hip_cooperative_groups.h>
#include <cstdio>
#include <cstdint>
namespace cg = cooperative_groups;
namespace pg8 {
#define PG8_LAS __attribute__((address_space(3)))
typedef unsigned short bf16_t;
typedef short bf16x8 __attribute__((ext_vector_type(8)));
typedef float f32x4 __attribute__((ext_vector_type(4)));
typedef unsigned u32x4 __attribute__((ext_vector_type(4)));
constexpr int BM = 256, BK = 64, HALF = 128, HTB = HALF * BK * 2  , STAGE_BYTES = 8 * HTB, NXCD = 8, WGM = 8;

__host__ __device__ __forceinline__ int lds_byte(int r, int c) { const int st = (r >> 4) * 2 + (c >> 5), rr = r & 15, cc = c & 31, ob = rr * 64 + cc * 2; return st * 1024 + (ob ^ (((ob >> 9) & 1) << 5)); }
__host__ __device__ __forceinline__ void stage_rc(int b, int& R, int& C) { const int st = b / 1024, sb = b % 1024, swz = sb ^ (((sb >> 9) & 1) << 5); R = (st >> 1) * 16 + swz / 64; C = (st & 1) * 32 + (swz % 64) / 2; }
__host__ __device__ __forceinline__ int perm32(int rho) { const int n = rho >> 4, i = rho & 15; return 8 * (i >> 2) + 4 * n + (i & 3); }

struct Unit { int pm, pn; };
struct Gemm { const bf16_t* A; const bf16_t* Bt; int M, N, K; };

struct StaticOrder {
    int nM, nN, nwg, G, c;
    __host__ __device__ void init(int M, int N, int G_, int c_) { nM = M / BM; nN = N / BM; nwg = nM * nN; G = G_; c = c_; }
    __host__ __device__ bool next(int i, Unit& u) const {
        const long L = (long)i * G + c; if (L >= nwg) return false;
        int wgid = (int)L; { const int q = nwg / NXCD, r = nwg % NXCD, xcd = wgid % NXCD, off = wgid / NXCD; wgid = (xcd < r ? xcd * (q + 1) : r * (q + 1) + (xcd - r) * q) + off; }
        const int nig = WGM * nN, gid = wgid / nig, fm = gid * WGM, gsz = (nM - fm) < WGM ? (nM - fm) : WGM;
        u.pm = fm + ((wgid % nig) % gsz); u.pn = (wgid % nig) / gsz; return true;
    }
    __device__ __forceinline__ void a_ready(const Unit&) const {}
    __device__ __forceinline__ void done(const Unit&) const {}
};

__device__ __forceinline__ unsigned cvt_pk_bf16(float lo, float hi) { unsigned r; asm volatile("v_cvt_pk_bf16_f32 %0, %1, %2" : "=v"(r) : "v"(lo), "v"(hi)); return r; }
template <int ACT> struct EpiBf16 {
    static constexpr bool PERM = true, AFTER_DRAIN = false;
    bf16_t* O; int ldc;
    __device__ __forceinline__ void operator()(const f32x4 (&acc)[2][2][4][2], const Unit& u, int wr, int wc, int fr, int fq) const {
        const int row0 = u.pm * BM + wr * 64 + fr; const int col0 = u.pn * BM + wc * 32 + 8 * fq;
#pragma unroll
        for (int ai = 0; ai < 2; ++ai)
#pragma unroll
            for (int m = 0; m < 4; ++m) { bf16_t* rowp = O + (size_t)(row0 + ai * HALF + m * 16) * ldc + col0;
#pragma unroll
                for (int bj = 0; bj < 2; ++bj) { f32x4 v0 = acc[ai][bj][m][0], v1 = acc[ai][bj][m][1];
                    if (ACT == 2) {
#pragma unroll
                        for (int e = 0; e < 4; ++e) { float a = v0[e] > 0.f ? v0[e] : 0.f; v0[e] = a * a; float b = v1[e] > 0.f ? v1[e] : 0.f; v1[e] = b * b; } }
                    u32x4 w; w.x = cvt_pk_bf16(v0[0], v0[1]); w.y = cvt_pk_bf16(v0[2], v0[3]); w.z = cvt_pk_bf16(v1[0], v1[1]); w.w = cvt_pk_bf16(v1[2], v1[3]);
                    *(u32x4*)(rowp + bj * HALF) = w; } }
    }
    __device__ __forceinline__ void fused(f32x4 (&)[2][2][4][2], const Unit&, int, int, int, int, PG8_LAS unsigned char*, int, int) const {}
};
struct EpiGlu {
    static constexpr bool PERM = true, AFTER_DRAIN = false;
    const bf16_t* Y_; const float* bias_; bf16_t* O; int ldo, coff;
    __device__ __forceinline__ void operator()(const f32x4 (&acc)[2][2][4][2], const Unit& u, int wr, int wc, int fr, int fq) const {
        const int row0 = u.pm * BM + wr * 64 + fr; const int col0 = u.pn * BM + wc * 32 + 8 * fq;
        const float* bias = bias_; const bf16_t* Y = Y_; asm volatile("" : "+s"(bias), "+s"(Y));
#pragma unroll
        for (int ai = 0; ai < 2; ++ai)
#pragma unroll
            for (int m = 0; m < 4; ++m) { const size_t row = (size_t)(row0 + ai * HALF + m * 16);
#pragma unroll
                for (int bj = 0; bj < 2; ++bj) { const int c = col0 + bj * HALF;
                    const f32x4 v0 = acc[ai][bj][m][0], v1 = acc[ai][bj][m][1];
                    const f32x4 b0 = *(const f32x4*)(bias + c), b1 = *(const f32x4*)(bias + c + 4);
                    const u32x4 yv = *(const u32x4*)(Y + row * 256 + c);
                    float y[8], o[8];
                    y[0] = __uint_as_float(yv.x << 16); y[1] = __uint_as_float(yv.x & 0xffff0000u); y[2] = __uint_as_float(yv.y << 16); y[3] = __uint_as_float(yv.y & 0xffff0000u);
                    y[4] = __uint_as_float(yv.z << 16); y[5] = __uint_as_float(yv.z & 0xffff0000u); y[6] = __uint_as_float(yv.w << 16); y[7] = __uint_as_float(yv.w & 0xffff0000u);
#pragma unroll
                    for (int e = 0; e < 4; ++e) { o[e] = y[e] * __builtin_amdgcn_rcpf(1.f + __expf(-(v0[e] + b0[e]))); o[4 + e] = y[4 + e] * __builtin_amdgcn_rcpf(1.f + __expf(-(v1[e] + b1[e]))); }
                    u32x4 w; w.x = cvt_pk_bf16(o[0], o[1]); w.y = cvt_pk_bf16(o[2], o[3]); w.z = cvt_pk_bf16(o[4], o[5]); w.w = cvt_pk_bf16(o[6], o[7]);
                    *(u32x4*)(O + row * ldo + coff + c) = w; }
                asm volatile("" ::: "memory"); }
    }
    __device__ __forceinline__ void fused(f32x4 (&)[2][2][4][2], const Unit&, int, int, int, int, PG8_LAS unsigned char*, int, int) const {}
};
template <class Epi, class Sched, bool ALIGN_EPI = false, bool SP2 = false>
__device__ __forceinline__ void gemm_phase(PG8_LAS unsigned char* lds, const Gemm g, const Sched& S, const Epi& E) {
    int tid_l = threadIdx.x; asm volatile("" : "+v"(tid_l));
    const int tid = tid_l, wid = __builtin_amdgcn_readfirstlane(tid >> 6), lane = tid & 63, wr = wid >> 2, wc = wid & 3, fr = lane & 15, fq = lane >> 4;
    const int K = g.K, nt = K / BK;
    unsigned voffA[2], voffB[2];
#pragma unroll
    for (int i = 0; i < 2; ++i) { int R, C; stage_rc(tid * 16 + i * 8192, R, C); const int Rb = Epi::PERM ? ((R & ~31) + perm32(R & 31)) : R;
        voffA[i] = (unsigned)(R * K + C) * 2u; voffB[i] = (unsigned)(Rb * K + C) * 2u; }
    const size_t kstep = (size_t)(BK * 2);
    const size_t hstep = (size_t)HALF * K * 2;
    const size_t tstep = 2 * hstep;
    const unsigned ldsw = (unsigned)wid * 1024u;
    const int aoff = lds_byte(wr * 64 + fr, fq * 8), boff = lds_byte(wc * 32 + fr, fq * 8);
#define PG8_SA(b, h) (((b) * 2 + (h)) * HTB)
#define PG8_SB(b, h) ((4 + (b) * 2 + (h)) * HTB)
#define PG8_STAGE(bufoff, gbase, voff) do { _Pragma("unroll") for (int _i = 0; _i < 2; ++_i) \
        __builtin_amdgcn_global_load_lds((const unsigned*)((const char*)(gbase) + (voff)[_i]), (PG8_LAS unsigned*)(lds + (bufoff) + ldsw + _i * 8192), 16, 0, 0); } while (0)
#define PG8_LDA(dst, b, h) do { _Pragma("unroll") for (int m = 0; m < 4; ++m) _Pragma("unroll") for (int k = 0; k < 2; ++k) dst[m][k] = *(const PG8_LAS bf16x8*)(lds + PG8_SA(b, h) + aoff + m * 2048 + k * 1024); } while (0)
#define PG8_LDB(dst, b, h) do { _Pragma("unroll") for (int n = 0; n < 2; ++n) _Pragma("unroll") for (int k = 0; k < 2; ++k) dst[n][k] = *(const PG8_LAS bf16x8*)(lds + PG8_SB(b, h) + boff + n * 2048 + k * 1024); } while (0)
#define PG8_MMA(ai, bj, At, Bt) do { __builtin_amdgcn_s_setprio(1); _Pragma("unroll") for (int m = 0; m < 4; ++m) _Pragma("unroll") for (int n = 0; n < 2; ++n) _Pragma("unroll") for (int k = 0; k < 2; ++k) \
        acc[ai][bj][m][n] = __builtin_amdgcn_mfma_f32_16x16x32_bf16(Bt[n][k], At[m][k], acc[ai][bj][m][n], 0, 0, 0); __builtin_amdgcn_s_setprio(0); } while (0)
#define PG8_WAIT_V(n) asm volatile("s_waitcnt vmcnt(" #n ")" ::: "memory")
#define PG8_WAIT_L(n) asm volatile("s_waitcnt lgkmcnt(" #n ")" ::: "memory")
#define PG8_BAR __builtin_amdgcn_s_barrier()
#define PG8_SCHED __builtin_amdgcn_sched_barrier(0)
    Unit cur, nxt; int ui = 0;
    if (!S.next(0, cur)) return;
    f32x4 acc[2][2][4][2];
#pragma unroll
    for (int a = 0; a < 2; ++a)
#pragma unroll
        for (int b = 0; b < 2; ++b)
#pragma unroll
            for (int m = 0; m < 4; ++m)
#pragma unroll
                for (int n = 0; n < 2; ++n) acc[a][b][m][n] = (f32x4){0.f, 0.f, 0.f, 0.f};
    bf16x8 At[4][2], B0[2][2], B1[2][2];
    const char* cA = (const char*)g.A + (size_t)cur.pm * tstep; const char* cB = (const char*)g.Bt + (size_t)cur.pn * tstep;
    S.a_ready(cur);
    if constexpr (SP2) {
        PG8_STAGE(PG8_SB(0, 0), cB, voffB); PG8_STAGE(PG8_SB(0, 1), cB + hstep, voffB); PG8_STAGE(PG8_SA(0, 0), cA, voffA); PG8_STAGE(PG8_SA(0, 1), cA + hstep, voffA);
        if (wr == 1) PG8_BAR;
        PG8_WAIT_V(2); PG8_BAR;
        PG8_STAGE(PG8_SB(1, 0), cB + kstep, voffB); PG8_STAGE(PG8_SA(1, 0), cA + kstep, voffA); PG8_STAGE(PG8_SB(1, 1), cB + hstep + kstep, voffB);
        PG8_WAIT_V(6); PG8_BAR;
    } else {
        PG8_STAGE(PG8_SB(0, 0), cB, voffB); PG8_STAGE(PG8_SA(0, 0), cA, voffA); PG8_STAGE(PG8_SB(0, 1), cB + hstep, voffB); PG8_STAGE(PG8_SA(0, 1), cA + hstep, voffA);
        if (wr == 1) PG8_BAR;
        PG8_WAIT_V(4); PG8_BAR;
        PG8_STAGE(PG8_SB(1, 0), cB + kstep, voffB); PG8_STAGE(PG8_SA(1, 0), cA + kstep, voffA); PG8_STAGE(PG8_SB(1, 1), cB + hstep + kstep, voffB);
        PG8_WAIT_V(6); PG8_BAR;
    }
    for (;;) {
        const bool has_next = S.next(ui + 1, nxt);
        const char* nA = has_next ? (const char*)g.A + (size_t)nxt.pm * tstep : cA; const char* nB = has_next ? (const char*)g.Bt + (size_t)nxt.pn * tstep : cB;
        for (int t = 0; t < nt; t += 2) {
            const bool last = (t == nt - 2);
            const char* a1 = cA + (size_t)(t + 1) * kstep;
            const char* a2 = last ? nA : cA + (size_t)(t + 2) * kstep; const char* b2 = last ? nB : cB + (size_t)(t + 2) * kstep;
            const char* a3 = a2 + kstep; const char* b3 = b2 + kstep;
            if (last && has_next) S.a_ready(nxt);
            if constexpr (SP2) {
            PG8_LDB(B0, 0, 0); PG8_LDB(B1, 0, 1); PG8_SCHED; PG8_LDA(At, 0, 0); PG8_STAGE(PG8_SA(1, 1), a1 + hstep, voffA);
            PG8_WAIT_V(8); PG8_WAIT_L(0); PG8_BAR; PG8_MMA(0, 0, At, B0); PG8_MMA(0, 1, At, B1); PG8_BAR; PG8_SCHED;
            PG8_LDA(At, 0, 1); PG8_STAGE(PG8_SB(0, 0), b2, voffB); PG8_STAGE(PG8_SB(0, 1), b2 + hstep, voffB); PG8_STAGE(PG8_SA(0, 0), a2, voffA);
            PG8_WAIT_V(8); PG8_WAIT_L(0); PG8_BAR; PG8_MMA(1, 0, At, B0); PG8_MMA(1, 1, At, B1); PG8_BAR; PG8_SCHED;
            PG8_LDB(B0, 1, 0); PG8_LDB(B1, 1, 1); PG8_SCHED; PG8_LDA(At, 1, 0); PG8_STAGE(PG8_SA(0, 1), a2 + hstep, voffA);
            PG8_WAIT_V(8); PG8_WAIT_L(0); PG8_BAR; PG8_MMA(0, 0, At, B0); PG8_MMA(0, 1, At, B1); PG8_BAR; PG8_SCHED;
            PG8_LDA(At, 1, 1); PG8_STAGE(PG8_SB(1, 0), b3, voffB); PG8_STAGE(PG8_SB(1, 1), b3 + hstep, voffB); PG8_STAGE(PG8_SA(1, 0), a3, voffA);
            PG8_WAIT_V(8); PG8_WAIT_L(0); PG8_BAR; PG8_MMA(1, 0, At, B0); PG8_MMA(1, 1, At, B1); PG8_BAR; PG8_SCHED;
            } else {
            PG8_LDB(B0, 0, 0); PG8_SCHED; PG8_LDA(At, 0, 0); PG8_STAGE(PG8_SA(1, 1), a1 + hstep, voffA);
            PG8_WAIT_L(8); PG8_BAR; PG8_WAIT_L(0); PG8_MMA(0, 0, At, B0); PG8_BAR; PG8_SCHED;
            PG8_LDB(B1, 0, 1); PG8_STAGE(PG8_SB(0, 0), b2, voffB);
            PG8_BAR; PG8_WAIT_L(0); PG8_MMA(0, 1, At, B1); PG8_BAR;
            PG8_LDA(At, 0, 1); PG8_STAGE(PG8_SA(0, 0), a2, voffA);
            PG8_BAR; PG8_WAIT_L(0); PG8_MMA(1, 0, At, B0); PG8_BAR; PG8_SCHED;
            PG8_STAGE(PG8_SB(0, 1), b2 + hstep, voffB);
            PG8_WAIT_V(6); PG8_BAR; PG8_MMA(1, 1, At, B1); PG8_BAR;
            PG8_LDB(B0, 1, 0); PG8_SCHED; PG8_LDA(At, 1, 0); PG8_STAGE(PG8_SA(0, 1), a2 + hstep, voffA);
            PG8_WAIT_L(8); PG8_BAR; PG8_WAIT_L(0); PG8_MMA(0, 0, At, B0); PG8_BAR; PG8_SCHED;
            PG8_LDB(B1, 1, 1); PG8_STAGE(PG8_SB(1, 0), b3, voffB);
            PG8_BAR; PG8_WAIT_L(0); PG8_MMA(0, 1, At, B1); PG8_BAR;
            PG8_LDA(At, 1, 1); PG8_STAGE(PG8_SA(1, 0), a3, voffA);
            PG8_BAR; PG8_WAIT_L(0); PG8_MMA(1, 0, At, B0); PG8_BAR; PG8_SCHED;
            PG8_STAGE(PG8_SB(1, 1), b3 + hstep, voffB);
            PG8_WAIT_V(6); PG8_BAR; PG8_MMA(1, 1, At, B1); PG8_BAR;
            }
        }
        if constexpr (ALIGN_EPI) { if (wr == 0) PG8_BAR; }
        if constexpr (!Epi::AFTER_DRAIN) { E(acc, cur, wr, wc, fr, fq); S.done(cur); }
        if (!has_next) break;
#pragma unroll
        for (int a = 0; a < 2; ++a)
#pragma unroll
            for (int b = 0; b < 2; ++b)
#pragma unroll
                for (int m = 0; m < 4; ++m)
#pragma unroll
                    for (int n = 0; n < 2; ++n) acc[a][b][m][n] = (f32x4){0.f, 0.f, 0.f, 0.f};
        cur = nxt; cA = nA; cB = nB; ++ui;
        if constexpr (ALIGN_EPI) { if (wr == 1) PG8_BAR; }
    }
    PG8_WAIT_V(0);
    if constexpr (!ALIGN_EPI) { if (wr == 0) PG8_BAR; }
    PG8_BAR;
    if constexpr (Epi::AFTER_DRAIN) { E.fused(acc, cur, wr, wc, fr, fq, lds, wid, lane); S.done(cur); }
#undef PG8_SA
#undef PG8_SB
#undef PG8_STAGE
#undef PG8_LDA
#undef PG8_LDB
#undef PG8_MMA
#undef PG8_WAIT_V
#undef PG8_WAIT_L
#undef PG8_BAR
#undef PG8_SCHED
}
}
#include <hip/hip_bf16.h>
#include <cmath>
namespace attn_body {
using bf16=__hip_bfloat16;
using bf16x8=__attribute__((ext_vector_type(8)))short;
using s16x4=__attribute__((ext_vector_type(4)))short;
using f32x16=__attribute__((ext_vector_type(16)))float;
using u32x4=__attribute__((ext_vector_type(4)))unsigned;
constexpr int BATCH=8,NHEAD=8,SEQ=4096,D=64,PQ=512,PV=2560;
constexpr int NW=8,QBLK=32,QB=QBLK*NW,KVBLK=64,NQB=SEQ/QB;
constexpr int ATTN_UNIT_ROWS=QB;
__device__ __forceinline__ int crow(int r,int hi){return (r&3)+8*(r>>2)+4*hi;}
#define SBAR() __builtin_amdgcn_sched_barrier(0)
__device__ __forceinline__ void cmask(f32x16&p0,f32x16&p1,int jb,int qrel,int hi){
  const float NEG=-INFINITY; int kb=64*jb+4*hi;
  #pragma unroll
  for(int r=0;r<16;++r){int kv=kb+(r&3)+8*(r>>2); if(kv>qrel)p0[r]=NEG; if(kv+32>qrel)p1[r]=NEG;}
}

constexpr int NSLOT=3, SLOTB=8192;
constexpr int LDS_K=0, LDS_V=NSLOT*SLOTB, LDS_WS=2*NSLOT*SLOTB, LDS_OST=LDS_WS+NW*64*4, LDS_BYTES=LDS_OST+NW*4096;
constexpr float C2=0.17677669529663687f*1.4426950408889634f;
__device__ __forceinline__ void glds16(const void*gsrc,unsigned lds_dst){unsigned keep;
  asm volatile("s_mov_b32 %0, m0\n\ts_mov_b32 m0, %2\n\ts_nop 0\n\tglobal_load_lds_dwordx4 %1, off\n\ts_mov_b32 m0, %0":"=&s"(keep):"v"(gsrc),"s"(lds_dst):"memory");}
__device__ __forceinline__ float max3f(float a,float b,float c){float r;asm("v_max3_f32 %0, %1, %2, %3":"=v"(r):"v"(a),"v"(b),"v"(c));return r;}
__device__ __forceinline__ float max2f(float a,float b){float r;asm("v_max_f32_e32 %0, %1, %2":"=v"(r):"v"(a),"v"(b));return r;}
__device__ __forceinline__ float fadd_s(float a,float b){float r;asm("v_add_f32_e32 %0, %1, %2":"=v"(r):"v"(a),"v"(b));return r;}
__device__ __forceinline__ float fsub_s(float a,float b){float r;asm("v_sub_f32_e32 %0, %1, %2":"=v"(r):"v"(a),"v"(b));return r;}
typedef float f32x2_t __attribute__((ext_vector_type(2))); typedef __bf16 bf16x2_t __attribute__((ext_vector_type(2)));
__device__ __forceinline__ unsigned cvtpk_s(float lo,float hi){f32x2_t v={lo,hi};bf16x2_t b=__builtin_convertvector(v,bf16x2_t);return __builtin_bit_cast(unsigned,b);}
#define WAIT_BAR(N) asm volatile("s_waitcnt vmcnt(" #N ") lgkmcnt(0)\n\ts_barrier":::"memory")

__device__ __forceinline__ void qkt(f32x16&p0,f32x16&p1,const char*Kslot,const bf16x8*qr,const f32x16&negm,int r32,int hi){
  const char*kb=Kslot+hi*1024+r32*16;
  #pragma unroll
  for(int d0=0;d0<2;++d0){
    const bf16x8 b0=*reinterpret_cast<const bf16x8*>(kb+d0*2048);
    const bf16x8 b1=*reinterpret_cast<const bf16x8*>(kb+d0*2048+512);
    if(d0==0){p0=__builtin_amdgcn_mfma_f32_32x32x16_bf16(b0,qr[0],negm,0,0,0);p1=__builtin_amdgcn_mfma_f32_32x32x16_bf16(b1,qr[0],negm,0,0,0);}
    else{p0=__builtin_amdgcn_mfma_f32_32x32x16_bf16(b0,qr[d0],p0,0,0,0);p1=__builtin_amdgcn_mfma_f32_32x32x16_bf16(b1,qr[d0],p1,0,0,0);}}
}
typedef __attribute__((address_space(3))) const char* lds_cptr;
typedef short v4i16_t __attribute__((ext_vector_type(4)));
__device__ __forceinline__ void kload8(bf16x8*kf,lds_cptr kp){
  kf[0]=*(const __attribute__((address_space(3))) bf16x8*)(kp);      kf[1]=*(const __attribute__((address_space(3))) bf16x8*)(kp+512);
  kf[2]=*(const __attribute__((address_space(3))) bf16x8*)(kp+2048); kf[3]=*(const __attribute__((address_space(3))) bf16x8*)(kp+2560);
}
__device__ __forceinline__ void kload2(bf16x8*kf,lds_cptr kp,int j){ kf[2*j]=*(const __attribute__((address_space(3))) bf16x8*)(kp+j*2048); kf[2*j+1]=*(const __attribute__((address_space(3))) bf16x8*)(kp+j*2048+512); }
__device__ __forceinline__ s16x4 vtr(lds_cptr p){ return __builtin_bit_cast(s16x4,__builtin_amdgcn_ds_read_tr16_b64_v4i16((__attribute__((address_space(3))) v4i16_t*)p)); }
__device__ __forceinline__ float rowmax(const f32x16&p0,const f32x16&p1){
  float a=max3f(p0[0],p0[1],p1[0]),b=max3f(p0[2],p0[3],p1[1]);a=max3f(a,p1[2],p1[3]);
  #pragma unroll
  for(int r=4;r<16;r+=4){a=max3f(a,p0[r],p0[r+1]);b=max3f(b,p0[r+2],p0[r+3]);a=max3f(a,p1[r],p1[r+1]);b=max3f(b,p1[r+2],p1[r+3]);}
  const float m=max2f(a,b);
  auto rr=__builtin_amdgcn_permlane32_swap(__float_as_uint(m),__float_as_uint(m),false,false);
  return max2f(__uint_as_float(rr[0]),__uint_as_float(rr[1]));
}
__device__ __forceinline__ void pv(f32x16*o,int vb,bf16x8 pa0,bf16x8 pa1,bf16x8 pa2,bf16x8 pa3){
  #pragma unroll
  for(int d0=0;d0<2;++d0){s16x4 lo[4],hi[4];
    #pragma unroll
    for(int ks=0;ks<4;++ks){
      asm volatile("ds_read_b64_tr_b16 %0,%1 offset:%c2":"=&v"(lo[ks]):"v"(vb),"i"(d0*4096+ks*1024):"memory");
      asm volatile("ds_read_b64_tr_b16 %0,%1 offset:%c2":"=&v"(hi[ks]):"v"(vb),"i"(d0*4096+ks*1024+512):"memory");}
    asm volatile("s_waitcnt lgkmcnt(0)":::"memory");SBAR();
    #define PK(k) (bf16x8){lo[k][0],lo[k][1],lo[k][2],lo[k][3],hi[k][0],hi[k][1],hi[k][2],hi[k][3]}
    o[d0]=__builtin_amdgcn_mfma_f32_32x32x16_bf16(pa0,PK(0),o[d0],0,0,0);
    o[d0]=__builtin_amdgcn_mfma_f32_32x32x16_bf16(pa1,PK(1),o[d0],0,0,0);
    o[d0]=__builtin_amdgcn_mfma_f32_32x32x16_bf16(pa2,PK(2),o[d0],0,0,0);
    o[d0]=__builtin_amdgcn_mfma_f32_32x32x16_bf16(pa3,PK(3),o[d0],0,0,0);
    #undef PK
  }
}

#ifndef ATTN_STORE16
#define ATTN_STORE16(p,v) (*(u32x4*)(p)=(v))
#endif
template<int THRL> __device__ __forceinline__ void attn_unit(int b,int h,int qb,const bf16*Q,const bf16*__restrict__ K,const bf16*__restrict__ V,bf16*O,char*shm){
  int tid_l=threadIdx.x; asm volatile("":"+v"(tid_l));
  const int tid=tid_l,lane=tid&63,r32=lane&31,hi=lane>>5; const int wid=__builtin_amdgcn_readfirstlane(tid>>6);
  const long rowbase=(long)b*SEQ; const int q0=qb*QB;
  const bf16*Qw=Q+(rowbase+q0+wid*QBLK)*PQ+h*D;
  const bf16*Kh=K+rowbase*PQ+h*D,*Vh=V+rowbase*PV+(h>>1)*D;
  const unsigned lds0=(unsigned)(uintptr_t)shm;
  float*wsf=(float*)(shm+LDS_WS)+wid*64;
  const bf16*ksrc=Kh+(long)lane*PQ+wid*8;
  const bf16*vsrc=Vh+(long)(16*(wid&3)+(lane>>2))*PV+(wid>>2)*32+(lane&3)*8;
  const unsigned kdst=lds0+LDS_K+wid*1024, vdst=lds0+LDS_V+wid*1024;
  #define DMA_K(t,slot) glds16(ksrc+(long)(t)*KVBLK*PQ,(unsigned)__builtin_amdgcn_readfirstlane(kdst+(slot)))
  #define DMA_V(t,slot) glds16(vsrc+(long)(t)*KVBLK*PV,(unsigned)__builtin_amdgcn_readfirstlane(vdst+(slot)))
  const int vb0=(int)(lds0+LDS_V)+((lane>>4)&1)*32+(lane&3)*8+(4*hi+((lane&15)>>2))*64;
  const char*Kbase=shm+LDS_K; bf16x8 kf[8];
  const lds_cptr shm3=(lds_cptr)shm; const lds_cptr kp0=shm3+LDS_K+hi*1024+r32*16; const lds_cptr vp0=shm3+LDS_V+((lane>>4)&1)*32+(lane&3)*8+(4*hi+((lane&15)>>2))*64;
  const int NT=(q0+QB)/KVBLK;
  DMA_K(0,0);DMA_V(0,0);DMA_K(1,SLOTB);
  bf16x8 qr[4];
  #pragma unroll
  for(int d0=0;d0<2;++d0)qr[d0]=*reinterpret_cast<const bf16x8*>(&Qw[(long)r32*PQ+d0*16+hi*8]);
  float mhat=0.f,l_reg=0.f;f32x16 o[2];o[0]=f32x16{};o[1]=f32x16{};f32x16 negm=f32x16{};asm volatile("":"+v"(negm));
  const int qrel=wid*QBLK+r32;
  #define CMASK(P0,P1,t) do{int jb_=(t)-(NT-4); if(jb_>=0)cmask(P0,P1,jb_,qrel,hi);}while(0)
  bool resc=false;
  #define START(P0,P1) do{ const float rm=rowmax(P0,P1); resc=false; \
    { const float dl=rm; mhat=fadd_s(mhat,dl); \
      _Pragma("unroll") for(int r=0;r<16;++r){P0[r]=fsub_s(P0[r],dl);P1[r]=fsub_s(P1[r],dl);} \
      _Pragma("unroll") for(int r=0;r<16;++r)negm[r]=-mhat; asm volatile("":"+v"(negm)); } \
    _Pragma("unroll") for(int r=0;r<16;++r)P0[r]=__builtin_amdgcn_exp2f(P0[r]); }while(0)
  #define RESC() do{ if(resc){ asm volatile("s_waitcnt lgkmcnt(0)":::"memory"); \
      _Pragma("unroll") for(int d_=0;d_<2;++d_) _Pragma("unroll") for(int r=0;r<16;++r)o[d_][r]*=wsf[crow(r,hi)]; } }while(0)
  f32x16 pA0,pA1,pB0,pB1;
  int sl_prev=0,sl_cur=0,sl_next=SLOTB;
  #define ROT() do{sl_prev=sl_cur;sl_cur=sl_next;sl_next=(sl_next==(NSLOT-1)*SLOTB)?0:sl_next+SLOTB;}while(0)
  DMA_K(2,2*SLOTB);
  WAIT_BAR(3);
  qkt(pA0,pA1,Kbase,qr,negm,r32,hi);asm volatile("s_nop 15\n\ts_nop 7":"+v"(pA0),"+v"(pA1));CMASK(pA0,pA1,0);
  START(pA0,pA1);
  _Pragma("unroll") for(int r=0;r<16;++r)pA1[r]=__builtin_amdgcn_exp2f(pA1[r]);
  WAIT_BAR(0);
  DMA_K(3,0);DMA_V(1,SLOTB);
  ROT();
  kload8(kf,kp0+sl_cur);
  WAIT_BAR(2);
  s16x4 vlo[8],vhi[8]; u32x4 pw0,pw1,pw2,pw3;
  #define PKW(P,B) cvtpk_s(P[B],P[B+1])
  #define PAF(k) __builtin_bit_cast(bf16x8,pw##k)
  #define VFR(i) (bf16x8){vlo[i][0],vlo[i][1],vlo[i][2],vlo[i][3],vhi[i][0],vhi[i][1],vhi[i][2],vhi[i][3]}
  #define PIN(x) asm volatile("":"+v"(x))
  #define MX3(a,b,c) __builtin_fmaxf(__builtin_fmaxf((a),(b)),(c))
  #define GAPA(MF,A0,A1,A2,A3,W0,W1,PW) do{ MF; sacc+=A0; sacc+=A1; sacc+=A2; sacc+=A3; PIN(sacc); W0; W1; PIN(PW); SBAR(); }while(0)
  #define EX(v) __builtin_amdgcn_exp2f(v)
  #define GAPB(MF,X,B) do{ MF; X[B]=EX(X[B]); X[B+1]=EX(X[B+1]); X[B+2]=EX(X[B+2]); X[B+3]=EX(X[B+3]); PIN(X); SBAR(); }while(0)
  #define VRD(i) do{ vlo[i]=vtr(vp_+(((i)>>2)*4096+((i)&3)*1024)); vhi[i]=vtr(vp_+(((i)>>2)*4096+((i)&3)*1024+512)); }while(0)
  #define KRD(G,j) do{ if(G){ kload2(kf,kp0+sl_next,j); SBAR(); } }while(0)
  #define STEP(C0,C1,P0,P1,t,GK,GV,GL) do{ SBAR(); \
    const lds_cptr vp_=vp0+sl_prev; \
    VRD(0); SBAR(); float sacc=(P0[0]+P0[1]); \
    GAPA(C0=__builtin_amdgcn_mfma_f32_32x32x16_bf16(kf[0],qr[0],negm,0,0,0), P0[2],P0[3],P0[4],P0[5],     pw0[0]=PKW(P0,0), pw0[1]=PKW(P0,2), pw0); \
    VRD(4); SBAR(); GAPA(C1=__builtin_amdgcn_mfma_f32_32x32x16_bf16(kf[1],qr[0],negm,0,0,0), P0[6],P0[7],P0[8],P0[9],     pw0[2]=PKW(P0,4), pw0[3]=PKW(P0,6), pw0); \
    VRD(1); SBAR(); GAPA(C0=__builtin_amdgcn_mfma_f32_32x32x16_bf16(kf[2],qr[1],C0,0,0,0),   P0[10],P0[11],P0[12],P0[13], pw1[0]=PKW(P0,8), pw1[1]=PKW(P0,10), pw1); \
    VRD(5); SBAR(); GAPA(C1=__builtin_amdgcn_mfma_f32_32x32x16_bf16(kf[3],qr[1],C1,0,0,0),   P0[14],P0[15],P1[0],P1[1],   pw1[2]=PKW(P0,12),pw1[3]=PKW(P0,14), pw1); \
    VRD(2); SBAR(); GAPA((void)0,   P1[2],P1[3],P1[4],P1[5],     pw2[0]=PKW(P1,0), pw2[1]=PKW(P1,2), pw2); \
    VRD(6); SBAR(); GAPA((void)0,   P1[6],P1[7],P1[8],P1[9],     pw2[2]=PKW(P1,4), pw2[3]=PKW(P1,6), pw2); \
    VRD(3); SBAR(); GAPA((void)0,   P1[10],P1[11],P1[12],P1[13], pw3[0]=PKW(P1,8), pw3[1]=PKW(P1,10), pw3); \
    VRD(7); SBAR(); GAPA((void)0,   P1[14],P1[15],0.f,0.f,       pw3[2]=PKW(P1,12),pw3[3]=PKW(P1,14), pw3); \
    l_reg+=sacc; \
    if(GK){DMA_K((t)+3,sl_cur);} if(GV){DMA_V((t)+1,sl_next);} \
    CMASK(C0,C1,t); \
    { float a=MX3(C0[0],C0[1],C1[0]),b=MX3(C0[2],C0[3],C1[1]); a=MX3(a,C1[2],C1[3]); \
      _Pragma("unroll") for(int r=4;r<16;r+=4){a=MX3(a,C0[r],C0[r+1]);b=MX3(b,C0[r+2],C0[r+3]);a=MX3(a,C1[r],C1[r+1]);b=MX3(b,C1[r+2],C1[r+3]);} \
      float rm=__builtin_fmaxf(a,b); { auto rr=__builtin_amdgcn_permlane32_swap(__float_as_uint(rm),__float_as_uint(rm),false,false); rm=__builtin_fmaxf(__uint_as_float(rr[0]),__uint_as_float(rr[1])); } \
      resc=false; \
      if(__builtin_expect(__any(rm>(float)THRL),0)){ const float dl=__builtin_fmaxf(rm,0.f); mhat+=dl; \
        _Pragma("unroll") for(int r=0;r<16;++r){C0[r]-=dl;C1[r]-=dl;} \
        _Pragma("unroll") for(int r=0;r<16;++r)negm[r]=-mhat; asm volatile("":"+v"(negm)); \
        const float f=__builtin_amdgcn_exp2f(-dl); l_reg*=f; if(hi==0)wsf[r32]=f; resc=true; } } \
    SBAR(); \
    GAPB(o[0]=__builtin_amdgcn_mfma_f32_32x32x16_bf16(PAF(0),VFR(0),o[0],0,0,0), C0,0); \
    GAPB(o[1]=__builtin_amdgcn_mfma_f32_32x32x16_bf16(PAF(0),VFR(4),o[1],0,0,0), C0,4); \
    KRD(GL,0); GAPB(o[0]=__builtin_amdgcn_mfma_f32_32x32x16_bf16(PAF(1),VFR(1),o[0],0,0,0), C0,8); \
    KRD(GL,1); GAPB(o[1]=__builtin_amdgcn_mfma_f32_32x32x16_bf16(PAF(1),VFR(5),o[1],0,0,0), C0,12); \
    GAPB(o[0]=__builtin_amdgcn_mfma_f32_32x32x16_bf16(PAF(2),VFR(2),o[0],0,0,0), C1,0); \
    GAPB(o[1]=__builtin_amdgcn_mfma_f32_32x32x16_bf16(PAF(2),VFR(6),o[1],0,0,0), C1,4); \
    GAPB(o[0]=__builtin_amdgcn_mfma_f32_32x32x16_bf16(PAF(3),VFR(3),o[0],0,0,0), C1,8); \
    GAPB(o[1]=__builtin_amdgcn_mfma_f32_32x32x16_bf16(PAF(3),VFR(7),o[1],0,0,0), C1,12); \
    }while(0)
  int t=1;
  #undef CMASK
  #define CMASK(P0,P1,t) do{}while(0)
  for(;t+5<NT;t+=2){
    STEP(pB0,pB1,pA0,pA1,t,true,true,true);     WAIT_BAR(2); RESC(); ROT();
    STEP(pA0,pA1,pB0,pB1,t+1,true,true,true);   WAIT_BAR(2); RESC(); ROT();
  }
  #undef CMASK
  #define CMASK(P0,P1,t) do{int jb_=(t)-(NT-4); if(jb_>=0)cmask(P0,P1,jb_,qrel,hi);}while(0)
  #define ENDW(tt) do{ if((tt)+3<NT){WAIT_BAR(2);} else if((tt)+2<NT){WAIT_BAR(1);} else {WAIT_BAR(0);} }while(0)
  for(;t+1<NT;t+=2){
    STEP(pB0,pB1,pA0,pA1,t,(t+3<NT),(t+1<NT),(t+1<NT));       ENDW(t);   RESC(); ROT();
    STEP(pA0,pA1,pB0,pB1,t+1,(t+4<NT),(t+2<NT),(t+2<NT));     ENDW(t+1); RESC(); ROT();
  }
  STEP(pB0,pB1,pA0,pA1,NT-1,false,false,false); RESC();
  { float sacc=pB0[0]+pB0[1]; _Pragma("unroll") for(int r=2;r<16;++r)sacc+=pB0[r]; _Pragma("unroll") for(int r=0;r<16;++r)sacc+=pB1[r]; l_reg+=sacc;
    pw0=(u32x4){PKW(pB0,0),PKW(pB0,2),PKW(pB0,4),PKW(pB0,6)};pw1=(u32x4){PKW(pB0,8),PKW(pB0,10),PKW(pB0,12),PKW(pB0,14)};pw2=(u32x4){PKW(pB1,0),PKW(pB1,2),PKW(pB1,4),PKW(pB1,6)};pw3=(u32x4){PKW(pB1,8),PKW(pB1,10),PKW(pB1,12),PKW(pB1,14)};
    SBAR(); pv(o,vb0+sl_cur,PAF(0),PAF(1),PAF(2),PAF(3)); }
  #undef PKW
  #undef PAF
  #undef VFR
  #undef PIN
  #undef MX3
  #undef GAPA
  #undef GAPB
  #undef EX
  #undef VRD
  #undef KRD
  #undef STEP
  #undef ENDW
  {auto rr=__builtin_amdgcn_permlane32_swap(__float_as_uint(l_reg),__float_as_uint(l_reg),false,false);l_reg=__uint_as_float(rr[0])+__uint_as_float(rr[1]);}
  if(hi==0)wsf[32+r32]=l_reg;asm volatile("s_waitcnt lgkmcnt(0)":::"memory");
  float rli[16];
  #pragma unroll
  for(int r=0;r<16;++r)rli[r]=__builtin_amdgcn_rcpf(wsf[32+crow(r,hi)]);
  bf16*Ow=O+(rowbase+q0+wid*QBLK)*PQ+h*D;
  { bf16*stg=(bf16*)(shm+LDS_OST)+wid*2048;
    #pragma unroll
    for(int r=0;r<16;++r){const int orow=crow(r,hi);
      #pragma unroll
      for(int d0=0;d0<2;++d0)stg[orow*64+d0*32+r32]=__float2bfloat16(o[d0][r]*rli[r]);}
    asm volatile("s_waitcnt lgkmcnt(0)":::"memory");
    #pragma unroll
    for(int i=0;i<4;++i){const int row=i*8+(lane>>3),ch=lane&7; const u32x4 v=*(const u32x4*)(stg+row*64+ch*8); ATTN_STORE16(Ow+(long)row*PQ+ch*8,v);} }
  asm volatile("s_waitcnt lgkmcnt(0)\n\ts_barrier":::"memory");
  #undef DMA_K
  #undef DMA_V
  #undef CMASK
  #undef START
  #undef RESC
  #undef ROT
}
constexpr int ATTN_LDS_BYTES=LDS_BYTES;
struct AttnTensors { const bf16* Q; const bf16* K; const bf16* V; bf16* O; };
struct AttnUnit { int bh; int qb; };
struct StaticOrder {
  int vcu,G;
  __device__ __forceinline__ explicit StaticOrder(int grid,int block):vcu((grid%8==0)?(block%8)*(grid/8)+block/8:block),G(grid){}
  __device__ __forceinline__ bool next(int i,AttnUnit&u)const{
    if(G==256){ if(i>=4)return false; const int s=vcu&3; u.bh=vcu>>2; u.qb=(i==0)?s:(i==1)?7-s:(i==2)?8+s:15-s; return true; }
    const int L=i*G+vcu; if(L>=BATCH*NHEAD*NQB)return false; u.bh=L/NQB; u.qb=NQB-1-(L%NQB); return true; }
  __device__ __forceinline__ void a_ready(const AttnUnit&)const{}
  __device__ __forceinline__ void done(const AttnUnit&)const{}
};
template<class Sched,int THRL=8> __device__ __forceinline__ void attn_phase(char*lds,const AttnTensors&T,const Sched&S){
  AttnUnit u;
  for(int i=0;S.next(i,u);++i){ S.a_ready(u); attn_unit<THRL>(u.bh/NHEAD,u.bh%NHEAD,u.qb,T.Q,T.K,T.V,T.O,lds); S.done(u); }
}
#undef SBAR
#undef WAIT_BAR
}
#define LAS __attribute__((address_space(3)))
typedef unsigned short bf16;
typedef float f32x4 __attribute__((ext_vector_type(4)));
typedef unsigned u32x4 __attribute__((ext_vector_type(4)));
typedef unsigned u32x2 __attribute__((ext_vector_type(2)));
constexpr int NB = 8, SEQ = 4096, T = NB * SEQ, DM = 1024, DFF = 4096, PP = 2560, NLAYER = 2, NWAVES = 8;
constexpr float EPS = 1e-6f;
constexpr int C_GQ = 0, C_GK = 128, C_GV = 256, C_GOG = 512, C_DQ = 768, C_DK = 1024, C_DV = 1280, C_SU = 1536, C_RX = 1792, C_RG = 2048, C_GLR = 2304;
__host__ __device__ __forceinline__ int win_src_col(int c) { return c < 512 ? c : (c < 2304 ? c + 16 : (c < 2320 ? 512 + (c - 2304) : -1)); }
constexpr size_t MiB = 1u << 20;
constexpr size_t WS_ROPE = 1 * MiB;
constexpr size_t WS_S5E = 2 * MiB;
constexpr size_t WS_LRUP = 3 * MiB;
constexpr size_t WS_LRUE = WS_LRUP + 512 * 1024;
constexpr size_t WS_GDEC = 4 * MiB;
constexpr size_t WS_WGLU = 5 * MiB;
constexpr size_t WS_WIN = 8 * MiB;
constexpr size_t WS_WOUT = 18 * MiB;
constexpr size_t WS_W1 = 22 * MiB;
constexpr size_t WS_W2 = 38 * MiB;
constexpr size_t WS_XF = 56 * MiB;
constexpr size_t WS_MIXO = 120 * MiB;
constexpr size_t WS_YS5 = 184 * MiB;
constexpr size_t WS_GLAS = 200 * MiB;
constexpr size_t WS_PROJ = 216 * MiB;
constexpr size_t WS_QP = 376 * MiB;
constexpr size_t WS_KP = 408 * MiB;
constexpr size_t WS_LH = 440 * MiB;
constexpr size_t WS_CP = 456 * MiB;
constexpr size_t WS_HID = 216 * MiB;
constexpr size_t WS_END = 472 * MiB;
constexpr int WLDS = 18432;
constexpr int LDS_BYTES = NWAVES * WLDS;
static_assert(LDS_BYTES >= pg8::STAGE_BYTES && LDS_BYTES >= attn_body::ATTN_LDS_BYTES, "lds");

__device__ __forceinline__ float bf2f(unsigned short b) { return __uint_as_float((unsigned)b << 16); }
__device__ __forceinline__ unsigned pk2(float lo, float hi) { return pg8::cvt_pk_bf16(lo, hi); }
__device__ __forceinline__ void unpack8(const u32x4 v, float* f) {
    f[0] = __uint_as_float(v.x << 16); f[1] = __uint_as_float(v.x & 0xffff0000u); f[2] = __uint_as_float(v.y << 16); f[3] = __uint_as_float(v.y & 0xffff0000u);
    f[4] = __uint_as_float(v.z << 16); f[5] = __uint_as_float(v.z & 0xffff0000u); f[6] = __uint_as_float(v.w << 16); f[7] = __uint_as_float(v.w & 0xffff0000u); }
__device__ __forceinline__ u32x4 pack8(const float* f) { u32x4 w; w.x = pk2(f[0], f[1]); w.y = pk2(f[2], f[3]); w.z = pk2(f[4], f[5]); w.w = pk2(f[6], f[7]); return w; }
__device__ __forceinline__ float sigmoidf_(float z) { return 1.f / (1.f + __expf(-z)); }
__device__ __forceinline__ float gelu_tanh(float x) { return x / (1.f + __expf(-1.5957691216057308f * (x + 0.044715f * x * x * x))); }
__device__ __forceinline__ float wave_sum(float v) {
#pragma unroll
    for (int o = 1; o < 64; o <<= 1) v += __shfl_xor(v, o);
    return v; }
#define WSYNC() asm volatile("s_waitcnt lgkmcnt(0)" ::: "memory")

struct Args { const float* in[34]; float* out; unsigned char* ws; };
typedef const float* const __attribute__((address_space(4)))* KIn;

template <bool WINMAP> __device__ __forceinline__ void transpose_item(const float* W, int K, int Nsrc, int Npad, bf16* WT, LAS float* scr, int item, int lane) {
    const int nblk = Npad / 32, kb = item / nblk, nb = item % nblk, k0 = 64 * kb, n0 = 32 * nb;
    const int nd = n0 + (lane & 31); const int ns = WINMAP ? win_src_col(nd) : nd;
#pragma unroll 8
    for (int i = 0; i < 32; ++i) { const int kk = 2 * i + (lane >> 5); scr[kk * 33 + (lane & 31)] = (ns >= 0) ? W[(size_t)(k0 + kk) * Nsrc + ns] : 0.f; }
    WSYNC();
    const int c = lane & 7;
#pragma unroll
    for (int j = 0; j < 4; ++j) { const int n = (lane >> 3) + 8 * j; const LAS float* s = scr + (8 * c) * 33 + n;
        u32x4 o; o.x = pk2(s[0 * 33], s[1 * 33]); o.y = pk2(s[2 * 33], s[3 * 33]); o.z = pk2(s[4 * 33], s[5 * 33]); o.w = pk2(s[6 * 33], s[7 * 33]);
        *(u32x4*)(WT + (size_t)(n0 + n) * K + k0 + 8 * c) = o; }
    WSYNC();
}
__device__ __forceinline__ void row_norm_to_bf16(const f32x4 (&v)[4], const float* g, bf16* orow, int lane) {
    float s = 0.f;
#pragma unroll
    for (int j = 0; j < 4; ++j) s += (v[j].x * v[j].x + v[j].y * v[j].y) + (v[j].z * v[j].z + v[j].w * v[j].w);
    const float rstd = rsqrtf(wave_sum(s) * (1.f / DM) + EPS);
#pragma unroll
    for (int j = 0; j < 4; ++j) { const f32x4 gg = *(const f32x4*)(g + 256 * j + 4 * lane);
        u32x2 w; w.x = pk2(v[j].x * rstd * gg.x, v[j].y * rstd * gg.y); w.y = pk2(v[j].z * rstd * gg.z, v[j].w * rstd * gg.w);
        *(u32x2*)(orow + 256 * j + 4 * lane) = w; }
}
__device__ __forceinline__ void phase_norm(const float* x, const float* g, bf16* XN, int gw, int NGW, int lane) {
    for (int m = gw; m < T; m += NGW) { f32x4 v[4];
#pragma unroll
        for (int j = 0; j < 4; ++j) v[j] = *(const f32x4*)(x + (size_t)m * DM + 256 * j + 4 * lane);
        row_norm_to_bf16(v, g, XN + (size_t)m * DM, lane); }
}
__device__ __forceinline__ void phase_res_norm(const float* xsrc, float* xdst, const bf16* Fb, const float* gpost, const float* gnext, bf16* XN, int gw, int NGW, int lane) {
    for (int m = gw; m < T; m += NGW) { f32x4 f[4], v[4]; float s = 0.f;
#pragma unroll
        for (int j = 0; j < 4; ++j) { const u32x2 w = *(const u32x2*)(Fb + (size_t)m * DM + 256 * j + 4 * lane);
            f[j].x = __uint_as_float(w.x << 16); f[j].y = __uint_as_float(w.x & 0xffff0000u); f[j].z = __uint_as_float(w.y << 16); f[j].w = __uint_as_float(w.y & 0xffff0000u);
            s += (f[j].x * f[j].x + f[j].y * f[j].y) + (f[j].z * f[j].z + f[j].w * f[j].w);
            v[j] = *(const f32x4*)(xsrc + (size_t)m * DM + 256 * j + 4 * lane); }
        const float rstd = rsqrtf(wave_sum(s) * (1.f / DM) + EPS);
#pragma unroll
        for (int j = 0; j < 4; ++j) { const f32x4 gg = *(const f32x4*)(gpost + 256 * j + 4 * lane);
            v[j].x += f[j].x * rstd * gg.x; v[j].y += f[j].y * rstd * gg.y; v[j].z += f[j].z * rstd * gg.z; v[j].w += f[j].w * rstd * gg.w;
            *(f32x4*)(xdst + (size_t)m * DM + 256 * j + 4 * lane) = v[j]; }
        if (gnext) row_norm_to_bf16(v, gnext, XN + (size_t)m * DM, lane); }
}
__device__ __forceinline__ void phase_rope(const bf16* proj, const float* tab, bf16* QP, bf16* KP, int gid, int gsz) {
    for (int idx = gid; idx < T * 32; idx += gsz) {
        const int row = idx >> 5, r = idx & 31, qk = r >> 4, hp = (r >> 1) & 7, d0 = (r & 1) * 8, pos = row & (SEQ - 1);
        const bf16* src = proj + (size_t)row * PP + (qk ? C_DK : C_DQ) + hp * 32 + d0;
        float x1[8], x2[8], o1[8], o2[8]; unpack8(*(const u32x4*)src, x1); unpack8(*(const u32x4*)(src + 16), x2);
        const float* tp = tab + pos * 32 + d0; const float sc = qk ? 1.f : attn_body::C2;
        const f32x4 c0 = *(const f32x4*)tp, c1 = *(const f32x4*)(tp + 4), s0 = *(const f32x4*)(tp + 16), s1 = *(const f32x4*)(tp + 20);
        const float cs[8] = {c0.x, c0.y, c0.z, c0.w, c1.x, c1.y, c1.z, c1.w}, sn[8] = {s0.x, s0.y, s0.z, s0.w, s1.x, s1.y, s1.z, s1.w};
#pragma unroll
        for (int i = 0; i < 8; ++i) { o1[i] = (x1[i] * cs[i] - x2[i] * sn[i]) * sc; o2[i] = (x2[i] * cs[i] + x1[i] * sn[i]) * sc; }
        bf16* dst = (qk ? KP : QP) + (size_t)row * 512 + hp * 64 + d0;
        *(u32x4*)dst = pack8(o1); *(u32x4*)(dst + 16) = pack8(o2);
        }
}
__device__ __forceinline__ void gla_gates(const bf16* prow, const float* wg, const float* bg, int h, int lane, float (&bc)[32], LAS float* Wst) {
#pragma unroll
    for (int r = 0; r < 8; ++r) { const int i = r * 64 + lane; Wst[i] = wg[(i >> 5) * 128 + h * 32 + (i & 31)]; }
    if (lane < 32) Wst[512 + lane] = bg[h * 32 + lane];
    float glr[16]; unpack8(*(const u32x4*)(prow + C_GLR), glr); unpack8(*(const u32x4*)(prow + C_GLR + 8), glr + 8);
    WSYNC();
#pragma unroll
    for (int d4 = 0; d4 < 8; ++d4) { f32x4 z = *(const LAS f32x4*)(Wst + 512 + 4 * d4);
#pragma unroll
        for (int r = 0; r < 16; ++r) { const f32x4 w = *(const LAS f32x4*)(Wst + r * 32 + 4 * d4); z += w * glr[r]; }
#pragma unroll
        for (int e = 0; e < 4; ++e) bc[4 * d4 + e] = (fminf(z[e], 0.f) - log1pf(__expf(-fabsf(z[e])))) * (1.f / 16.f); }
    WSYNC();
#pragma unroll
    for (int d = 0; d < 32; ++d) { float v = bc[d];
#pragma unroll
        for (int off = 1; off < 64; off <<= 1) { const float t = __shfl_up(v, off); if (lane >= off) v += t; }
        bc[d] = v; }
}
__device__ __forceinline__ void gla_local_unit(int u, const bf16* proj, const float* wg, const float* bg, float* KV, float* DEC, LAS unsigned char* wl, int lane) {
    const int b = u >> 8, h = (u >> 6) & 3, n = u & 63; const size_t row = (size_t)b * SEQ + n * 64 + lane; const bf16* prow = proj + row * PP;
    LAS float* A = (LAS float*)wl; LAS bf16* Bv = (LAS bf16*)(wl + 9216);
    float bc[32]; gla_gates(prow, wg, bg, h, lane, bc, (LAS float*)(wl + 9216));
    float k[32];
#pragma unroll
    for (int i = 0; i < 4; ++i) unpack8(*(const u32x4*)(prow + C_GK + h * 32 + 8 * i), k + 8 * i);
#pragma unroll
    for (int d4 = 0; d4 < 8; ++d4) { f32x4 w;
#pragma unroll
        for (int e = 0; e < 4; ++e) { const int d = 4 * d4 + e; const float bl = __shfl(bc[d], 63); w[e] = k[d] * __expf(bl - bc[d]); }
        *(LAS f32x4*)(A + lane * 36 + 4 * d4) = w; }
#pragma unroll
    for (int i = 0; i < 8; ++i) *(LAS u32x4*)(Bv + lane * 64 + 8 * i) = *(const u32x4*)(prow + C_GV + h * 64 + 8 * i);
    WSYNC();
    float acc[32];
#pragma unroll
    for (int d = 0; d < 32; ++d) acc[d] = 0.f;
    for (int j = 0; j < 64; ++j) { const float vv = bf2f(Bv[j * 64 + lane]);
#pragma unroll
        for (int d4 = 0; d4 < 8; ++d4) { const f32x4 k4 = *(const LAS f32x4*)(A + j * 36 + 4 * d4);
#pragma unroll
            for (int e = 0; e < 4; ++e) acc[4 * d4 + e] += k4[e] * vv; } }
#pragma unroll
    for (int d = 0; d < 32; ++d) KV[((size_t)u * 32 + d) * 64 + lane] = acc[d];
    if (lane == 63) {
#pragma unroll
        for (int d = 0; d < 32; ++d) DEC[u * 32 + d] = __expf(bc[d]); }
    WSYNC();
}
__device__ __forceinline__ void gla_out_unit(int u, const bf16* proj, const float* wg, const float* bg, const float* gn, const float* SP, bf16* MIXO, LAS unsigned char* wl, int lane) {
    const int b = u >> 8, h = (u >> 6) & 3, n = u & 63; const size_t row = (size_t)b * SEQ + n * 64 + lane; const bf16* prow = proj + row * PP;
    LAS float* A = (LAS float*)wl; LAS bf16* Bv = (LAS bf16*)(wl + 9216);
    float bc[32]; gla_gates(prow, wg, bg, h, lane, bc, (LAS float*)(wl + 9216));
    float qd[32];
    { float k[32], q[32];
#pragma unroll
      for (int i = 0; i < 4; ++i) { unpack8(*(const u32x4*)(prow + C_GK + h * 32 + 8 * i), k + 8 * i); unpack8(*(const u32x4*)(prow + C_GQ + h * 32 + 8 * i), q + 8 * i); }
#pragma unroll
      for (int d4 = 0; d4 < 8; ++d4) { f32x4 w;
#pragma unroll
          for (int e = 0; e < 4; ++e) { const int d = 4 * d4 + e; const float ex = __expf(bc[d]); qd[d] = q[d] * 0.17677669529663687f * ex; w[e] = k[d] * __expf(-bc[d]); }
          *(LAS f32x4*)(A + lane * 36 + 4 * d4) = w; } }
#pragma unroll
    for (int i = 0; i < 8; ++i) *(LAS u32x4*)(Bv + lane * 64 + 8 * i) = *(const u32x4*)(prow + C_GV + h * 64 + 8 * i);
    WSYNC();
    float o[64];
#pragma unroll
    for (int v = 0; v < 64; ++v) o[v] = 0.f;
    for (int i = 0; i < 64; ++i) { float a = 0.f;
#pragma unroll
        for (int d4 = 0; d4 < 8; ++d4) { const f32x4 k4 = *(const LAS f32x4*)(A + i * 36 + 4 * d4);
#pragma unroll
            for (int e = 0; e < 4; ++e) a += qd[4 * d4 + e] * k4[e]; }
        a = (i <= lane) ? a : 0.f;
#pragma unroll
        for (int v8 = 0; v8 < 8; ++v8) { float vv[8]; unpack8(*(const LAS u32x4*)(Bv + i * 64 + 8 * v8), vv);
#pragma unroll
            for (int e = 0; e < 8; ++e) o[8 * v8 + e] += a * vv[e]; } }
    WSYNC();
    const float* sp = SP + (size_t)u * 2048;
#pragma unroll 8
    for (int d = 0; d < 32; ++d) A[d * 64 + lane] = sp[d * 64 + lane];
    WSYNC();
#pragma unroll
    for (int d = 0; d < 32; ++d) {
#pragma unroll
        for (int v4 = 0; v4 < 16; ++v4) { const f32x4 s4 = *(const LAS f32x4*)(A + d * 64 + 4 * v4);
#pragma unroll
            for (int e = 0; e < 4; ++e) o[4 * v4 + e] += qd[d] * s4[e]; } }
    float ss = 0.f;
#pragma unroll
    for (int v = 0; v < 64; ++v) ss += o[v] * o[v];
    const float rstd = rsqrtf(ss * (1.f / 64.f) + EPS);
#pragma unroll
    for (int v8 = 0; v8 < 8; ++v8) { float og[8], w[8]; unpack8(*(const u32x4*)(prow + C_GOG + h * 64 + 8 * v8), og);
#pragma unroll
        for (int e = 0; e < 8; ++e) { const float z = og[e]; w[e] = o[8 * v8 + e] * rstd * gn[8 * v8 + e] * (z * sigmoidf_(z)); }
        *(u32x4*)(MIXO + row * DM + h * 64 + 8 * v8) = pack8(w); }
    WSYNC();
}
struct S5P { float abr, abi; float bbr[16], bbi[16]; };
__device__ __forceinline__ void s5_ab(KIn in, int l, int g, int p, float& abr, float& abi, float& cr, float& ci) {
    const float step = __expf(in[15][l * 16 + g]); const float lr = in[16][(l * 16 + g) * 64 + p], li = in[17][(l * 16 + g) * 64 + p];
    const float mag = expf(lr * step); abr = mag * cosf(li * step); abi = mag * sinf(li * step);
    const float den = lr * lr + li * li, nr = abr - 1.f, ni = abi; cr = (nr * lr + ni * li) / den; ci = (ni * lr - nr * li) / den;
}
__device__ __forceinline__ void s5_params(KIn in, int l, int g, int p, S5P& P) {
    float cr, ci; s5_ab(in, l, g, p, P.abr, P.abi, cr, ci);
    const float* br = in[18] + ((size_t)(l * 16 + g) * 64 + p) * 16; const float* bi = in[19] + ((size_t)(l * 16 + g) * 64 + p) * 16;
#pragma unroll
    for (int h4 = 0; h4 < 4; ++h4) { const f32x4 r = *(const f32x4*)(br + 4 * h4), i = *(const f32x4*)(bi + 4 * h4);
#pragma unroll
        for (int e = 0; e < 4; ++e) { P.bbr[4 * h4 + e] = cr * r[e] - ci * i[e]; P.bbi[4 * h4 + e] = cr * i[e] + ci * r[e]; } }
}
__device__ __forceinline__ void s5_step(const S5P& P, const LAS float* urow, float& xr, float& xi) {
    float br = 0.f, bi = 0.f;
#pragma unroll
    for (int h4 = 0; h4 < 4; ++h4) { const f32x4 u4 = *(const LAS f32x4*)(urow + 4 * h4);
#pragma unroll
        for (int e = 0; e < 4; ++e) { br += P.bbr[4 * h4 + e] * u4[e]; bi += P.bbi[4 * h4 + e] * u4[e]; } }
    const float nr = P.abr * xr - P.abi * xi + br, ni = P.abr * xi + P.abi * xr + bi; xr = nr; xi = ni;
}
__device__ __forceinline__ void s5_local_unit(int u, int l, KIn in, const bf16* proj, float* E, LAS unsigned char* wl, int lane) {
    const int b = u >> 8, g = (u >> 4) & 15, c = u & 15; const size_t r0 = (size_t)b * SEQ + c * 256;
    LAS float* U = (LAS float*)wl;
    S5P P; s5_params(in, l, g, lane, P);
#pragma unroll
    for (int it = 0; it < 8; ++it) { const int tok = it * 32 + (lane >> 1), hf = lane & 1; float f[8];
        unpack8(*(const u32x4*)(proj + (r0 + tok) * PP + C_SU + g * 16 + hf * 8), f);
        *(LAS f32x4*)(U + tok * 16 + hf * 8) = (f32x4){f[0], f[1], f[2], f[3]}; *(LAS f32x4*)(U + tok * 16 + hf * 8 + 4) = (f32x4){f[4], f[5], f[6], f[7]}; }
    WSYNC();
    float xr = 0.f, xi = 0.f;
#pragma unroll 4
    for (int t = 0; t < 256; ++t) s5_step(P, U + t * 16, xr, xi);
    E[((size_t)u * 64 + lane) * 2] = xr; E[((size_t)u * 64 + lane) * 2 + 1] = xi;
    WSYNC();
}
__device__ __forceinline__ void s5_out_unit(int u, int l, KIn in, const bf16* proj, const float* E, bf16* YS, LAS unsigned char* wl, int lane) {
    const int b = u >> 8, g = (u >> 4) & 15, c = u & 15; const size_t r0 = (size_t)b * SEQ + c * 256;
    LAS float* XR = (LAS float*)wl; LAS float* XI = XR + 16 * 68; LAS float* U = XI + 16 * 68; LAS float* Cm = U + 256;
    S5P P; s5_params(in, l, g, lane, P);
    { const float* cre = in[20] + (size_t)(l * 16 + g) * 1024; const float* cim = in[21] + (size_t)(l * 16 + g) * 1024;
#pragma unroll 4
      for (int q = 0; q < 16; ++q) { Cm[lane * 32 + q] = cre[q * 64 + lane]; Cm[lane * 32 + 16 + q] = cim[q * 64 + lane]; } }
    float xr = 0.f, xi = 0.f;
    { float ar = P.abr, ai = P.abi;
#pragma unroll
      for (int s = 0; s < 8; ++s) { const float nr = ar * ar - ai * ai, ni = 2.f * ar * ai; ar = nr; ai = ni; }
      for (int cc = 0; cc < c; ++cc) { const size_t idx = ((size_t)(u - c + cc) * 64 + lane) * 2; const float er = E[idx], ei = E[idx + 1];
          const float nr = ar * xr - ai * xi + er, ni = ar * xi + ai * xr + ei; xr = nr; xi = ni; } }
    const int t = lane & 15, qq = lane >> 4;
    const f32x4 dv = *(const f32x4*)(in[22] + l * 256 + g * 16 + qq * 4);
    for (int tt = 0; tt < 16; ++tt) {
        if (lane < 32) { const int tok = lane >> 1, hf = lane & 1; float f[8];
            unpack8(*(const u32x4*)(proj + (r0 + tt * 16 + tok) * PP + C_SU + g * 16 + hf * 8), f);
            *(LAS f32x4*)(U + tok * 16 + hf * 8) = (f32x4){f[0], f[1], f[2], f[3]}; *(LAS f32x4*)(U + tok * 16 + hf * 8 + 4) = (f32x4){f[4], f[5], f[6], f[7]}; }
        WSYNC();
#pragma unroll 4
        for (int s = 0; s < 16; ++s) { s5_step(P, U + s * 16, xr, xi); XR[s * 68 + lane] = xr; XI[s * 68 + lane] = xi; }
        WSYNC();
        f32x4 y = {0.f, 0.f, 0.f, 0.f};
#pragma unroll 4
        for (int p4 = 0; p4 < 16; ++p4) { const f32x4 a = *(const LAS f32x4*)(XR + t * 68 + 4 * p4), bb = *(const LAS f32x4*)(XI + t * 68 + 4 * p4);
#pragma unroll
            for (int e = 0; e < 4; ++e) { const f32x4 cr4 = *(const LAS f32x4*)(Cm + (4 * p4 + e) * 32 + qq * 4), ci4 = *(const LAS f32x4*)(Cm + (4 * p4 + e) * 32 + 16 + qq * 4);
                y += cr4 * a[e] - ci4 * bb[e]; } }
        const f32x4 uu = *(const LAS f32x4*)(U + t * 16 + qq * 4);
        y += dv * uu;
        u32x2 w; w.x = pk2(gelu_tanh(y.x), gelu_tanh(y.y)); w.y = pk2(gelu_tanh(y.z), gelu_tanh(y.w));
        *(u32x2*)(YS + (r0 + tt * 16 + t) * 256 + g * 16 + qq * 4) = w;
        WSYNC();
    }
}
__device__ __forceinline__ void lru_local_unit(int u, int l, KIn in, const bf16* proj, float* PR, float* EN, bf16* LH, bf16* CP, LAS unsigned char* wl, int lane) {
    const int b = u >> 8, n = (u >> 6) & 3, c = u & 63, col = n * 64 + lane; const size_t r0 = (size_t)b * SEQ + c * 64;
    LAS float* XC = (LAS float*)wl;
    const float* cw = in[25] + l * 1024; const float cw0 = cw[col], cw1 = cw[256 + col], cw2 = cw[512 + col], cw3 = cw[768 + col], cb = in[26][l * 256 + col];
    const bf16* xp = proj + r0 * PP + C_RX + col;
    float xm3 = 0.f, xm2 = 0.f, xm1 = 0.f;
    if (c > 0) { xm3 = bf2f(*(xp - 3 * PP)); xm2 = bf2f(*(xp - 2 * PP)); xm1 = bf2f(*(xp - PP)); }
#pragma unroll 8
    for (int t = 0; t < 64; ++t) { const float xt = bf2f(xp[(size_t)t * PP]); XC[t * 64 + lane] = cb + cw0 * xm3 + cw1 * xm2 + cw2 * xm1 + cw3 * xt; xm3 = xm2; xm2 = xm1; xm1 = xt; }
    float wa[64], wx[64];
    { const float* pa = in[27] + (size_t)(l * 4 + n) * 4096 + lane; const float* px = in[29] + (size_t)(l * 4 + n) * 4096 + lane;
#pragma unroll
      for (int k = 0; k < 64; ++k) { wa[k] = pa[k * 64]; wx[k] = px[k * 64]; } }
    const float ba = in[28][l * 256 + col], bx = in[30][l * 256 + col];
    const float sp8 = -8.f * log1pf(expf(-in[31][l * 256 + col]));
    WSYNC();
    float h = 0.f, cp = 1.f;
    for (int t = 0; t < 64; ++t) { float ra = ba, ia = bx;
#pragma unroll
        for (int k4 = 0; k4 < 16; ++k4) { const f32x4 x4 = *(const LAS f32x4*)(XC + t * 64 + 4 * k4);
#pragma unroll
            for (int e = 0; e < 4; ++e) { ra += x4[e] * wa[4 * k4 + e]; ia += x4[e] * wx[4 * k4 + e]; } }
        const float own = XC[t * 64 + lane];
        const float r = sigmoidf_(ra), ig = sigmoidf_(ia), la = sp8 * r, a = __expf(la), mult = sqrtf(fmaxf(-expm1f(2.f * la), 1e-12f));
        h = a * h + mult * ig * own; cp *= a;
        LH[(r0 + t) * 256 + col] = (bf16)(pk2(h, 0.f) & 0xffffu); CP[(r0 + t) * 256 + col] = (bf16)(pk2(cp, 0.f) & 0xffffu); }
    PR[(size_t)(b * 64 + c) * 256 + col] = cp; EN[(size_t)(b * 64 + c) * 256 + col] = h;
    WSYNC();
}
__device__ __forceinline__ void phase_carries(float* GLAS, const float* GDEC, const float* LRUP, float* LRUE, int gid, int gsz) {
    for (int e = gid; e < 65536 + 2048; e += gsz) {
        if (e < 65536) { const int bh = e >> 11, dv = e & 2047, d = dv >> 6; float S = 0.f;
            for (int n = 0; n < 64; ++n) { const size_t idx = ((size_t)(bh * 64 + n)) * 2048 + dv; const float kv = GLAS[idx], dc = GDEC[(bh * 64 + n) * 32 + d]; GLAS[idx] = S; S = dc * S + kv; }
        } else { const int q = e - 65536, b = q >> 8, col = q & 255; float H = 0.f;
            for (int c = 0; c < 64; ++c) { const size_t idx = (size_t)(b * 64 + c) * 256 + col; const float p = LRUP[idx], en = LRUE[idx]; LRUE[idx] = H; H = p * H + en; } }
    }
}
__device__ __forceinline__ void phase_lru_out(const bf16* proj, const bf16* LH, const bf16* CP, const float* HIN, bf16* MIXO, int gid, int gsz) {
    for (int idx = gid; idx < T * 32; idx += gsz) { const int row = idx >> 5, c8 = (idx & 31) * 8, b = row >> 12, ch = (row & (SEQ - 1)) >> 6;
        float lh[8], cp[8], gt[8], o[8]; unpack8(*(const u32x4*)(LH + (size_t)row * 256 + c8), lh); unpack8(*(const u32x4*)(CP + (size_t)row * 256 + c8), cp);
        unpack8(*(const u32x4*)(proj + (size_t)row * PP + C_RG + c8), gt);
        const float* hp = HIN + (size_t)(b * 64 + ch) * 256 + c8; const f32x4 h0 = *(const f32x4*)hp, h1 = *(const f32x4*)(hp + 4);
        const float hin[8] = {h0.x, h0.y, h0.z, h0.w, h1.x, h1.y, h1.z, h1.w};
#pragma unroll
        for (int e = 0; e < 8; ++e) o[e] = (lh[e] + cp[e] * hin[e]) * gelu_tanh(gt[e]);
        *(u32x4*)(MIXO + (size_t)row * DM + 768 + c8) = pack8(o); }
}
__device__ __forceinline__ void phase_diff_out(int l, KIn in, const bf16* OP, bf16* MIXO, int gid, int gsz) {
    float s1 = 0.f, s2 = 0.f;
    for (int i = 0; i < 32; ++i) { s1 += in[10][l * 32 + i] * in[11][l * 32 + i]; s2 += in[12][l * 32 + i] * in[13][l * 32 + i]; }
    const float lam_init = 0.8f - 0.6f * expf(-0.3f * (float)l), lam = expf(s1) - expf(s2) + lam_init, osc = 1.f - lam_init;
    const float* dn = in[14] + l * 64;
    for (int idx = gid; idx < T * 32; idx += gsz) { const int row = idx >> 5, h = (idx >> 3) & 3, v8 = (idx & 7) * 8;
        float a[8], bq[8], o[8]; unpack8(*(const u32x4*)(OP + (size_t)row * 512 + (2 * h) * 64 + v8), a); unpack8(*(const u32x4*)(OP + (size_t)row * 512 + (2 * h + 1) * 64 + v8), bq);
        float ss = 0.f;
#pragma unroll
        for (int e = 0; e < 8; ++e) { o[e] = a[e] - lam * bq[e]; ss += o[e] * o[e]; }
        ss += __shfl_xor(ss, 1); ss += __shfl_xor(ss, 2); ss += __shfl_xor(ss, 4);
        const float rstd = rsqrtf(ss * (1.f / 64.f) + EPS) * osc;
#pragma unroll
        for (int e = 0; e < 8; ++e) o[e] = o[e] * rstd * dn[v8 + e];
        *(u32x4*)(MIXO + (size_t)row * DM + 256 + h * 64 + v8) = pack8(o); }
}

__device__ __forceinline__ void phase_glu_gate(const bf16* YS, const bf16* ZG, const float* bias, bf16* MIXO, int gid, int gsz) {
    for (int idx = gid; idx < T * 32; idx += gsz) { const int row = idx >> 5, c8 = (idx & 31) * 8;
        float y[8], z[8], o[8]; unpack8(*(const u32x4*)(YS + (size_t)row * 256 + c8), y); unpack8(*(const u32x4*)(ZG + (size_t)row * 256 + c8), z);
        const f32x4 b0 = *(const f32x4*)(bias + c8), b1 = *(const f32x4*)(bias + c8 + 4); const float bb[8] = {b0.x, b0.y, b0.z, b0.w, b1.x, b1.y, b1.z, b1.w};
#pragma unroll
        for (int e = 0; e < 8; ++e) o[e] = y[e] * sigmoidf_(z[e] + bb[e]);
        *(u32x4*)(MIXO + (size_t)row * DM + 512 + c8) = pack8(o); }
}

#define PH_BEGIN { int tid_ = threadIdx.x; asm volatile("" : "+v"(tid_)); KIn in; { auto kp_ = __builtin_amdgcn_kernarg_segment_ptr(); asm volatile("" : "+s"(kp_)); in = (KIn)kp_; } \
    float* out = (float*)in[34]; unsigned char* ws = (unsigned char*)in[35]; \
    const int tid = tid_, lane = tid & 63, wave = __builtin_amdgcn_readfirstlane(tid >> 6); int G_ = gridDim.x, bx_ = blockIdx.x; asm volatile("" : "+s"(G_), "+s"(bx_)); const int G = G_, bx = bx_; \
    const int gw = bx * NWAVES + wave, NGW = G * NWAVES, gid = bx * (NWAVES * 64) + tid, gsz = G * NWAVES * 64; LAS unsigned char* wl = lds + wave * WLDS; \
    (void)lane; (void)gw; (void)NGW; (void)gid; (void)gsz; (void)wl; (void)ws; (void)out;
#define PH_END }
#define WSB(off) ((bf16*)(ws + (off)))
#define WSF(off) ((float*)(ws + (off)))
__global__ void __launch_bounds__(NWAVES * 64) fwd_megakernel(Args args) {
    extern __shared__ __attribute__((aligned(16))) unsigned char lds_raw[];
    cg::grid_group grid = cg::this_grid();
    LAS unsigned char* lds = (LAS unsigned char*)lds_raw;

    PH_BEGIN
        LAS float* scr = (LAS float*)wl;
        constexpr int I_IN = 16 * 80, I_OUT = 16 * 32, I_1 = 16 * 128, I_2 = 64 * 32, I_G = 4 * 8, I_L = I_IN + I_OUT + I_1 + I_2 + I_G;
        for (int it = gw; it < NLAYER * I_L; it += NGW) { const int l = it / I_L; int r = it % I_L;
            if (r < I_IN) { transpose_item<true>(in[5] + (size_t)l * DM * 2320, DM, 2320, PP, WSB(WS_WIN) + (size_t)l * PP * DM, scr, r, lane); continue; } r -= I_IN;
            if (r < I_OUT) { transpose_item<false>(in[6] + (size_t)l * DM * DM, DM, DM, DM, WSB(WS_WOUT) + (size_t)l * DM * DM, scr, r, lane); continue; } r -= I_OUT;
            if (r < I_1) { transpose_item<false>(in[32] + (size_t)l * DM * DFF, DM, DFF, DFF, WSB(WS_W1) + (size_t)l * DM * DFF, scr, r, lane); continue; } r -= I_1;
            if (r < I_2) { transpose_item<false>(in[33] + (size_t)l * DM * DFF, DFF, DM, DM, WSB(WS_W2) + (size_t)l * DM * DFF, scr, r, lane); continue; } r -= I_2;
            transpose_item<false>(in[23] + (size_t)l * 65536, 256, 256, 256, WSB(WS_WGLU) + (size_t)l * 65536, scr, r, lane); }
        float* ROPE = WSF(WS_ROPE);
        for (int idx = gid; idx < SEQ * 16; idx += gsz) { const int pos = idx >> 4, j = idx & 15; const float inv = powf(10000.f, -(float)j * (1.f / 16.f)); const float ang = (float)pos * inv;
            ROPE[pos * 32 + j] = cosf(ang); ROPE[pos * 32 + 16 + j] = sinf(ang); }
        phase_norm(in[0], in[1], WSB(WS_XF), gw, NGW, lane);
    PH_END
    grid.sync();
#pragma unroll
    for (int l = 0; l < NLAYER; ++l) {
        PH_BEGIN
          pg8::Gemm g{WSB(WS_XF), WSB(WS_WIN) + (size_t)l * PP * DM, T, PP, DM}; pg8::StaticOrder S; S.init(T, PP, G, bx);
          pg8::EpiBf16<0> E{WSB(WS_PROJ), PP}; pg8::gemm_phase<pg8::EpiBf16<0>, pg8::StaticOrder, true, true>(lds, g, S, E);
        PH_END
        grid.sync();
        PH_BEGIN phase_rope(WSB(WS_PROJ), WSF(WS_ROPE), WSB(WS_QP), WSB(WS_KP), gid, gsz); PH_END
        PH_BEGIN for (int u = gw; u < 2048; u += NGW) gla_local_unit(u, WSB(WS_PROJ), in[7] + l * 2048, in[8] + l * 128, WSF(WS_GLAS), WSF(WS_GDEC), wl, lane); PH_END
        PH_BEGIN for (int u = gw; u < 2048; u += NGW) s5_local_unit(u, l, in, WSB(WS_PROJ), WSF(WS_S5E), wl, lane); PH_END
        PH_BEGIN for (int u = gw; u < 2048; u += NGW) lru_local_unit(u, l, in, WSB(WS_PROJ), WSF(WS_LRUP), WSF(WS_LRUE), WSB(WS_LH), WSB(WS_CP), wl, lane); PH_END
        grid.sync();
        PH_BEGIN for (int u = gw; u < 2048; u += NGW) s5_out_unit(u, l, in, WSB(WS_PROJ), WSF(WS_S5E), WSB(WS_YS5), wl, lane); PH_END
        PH_BEGIN phase_carries(WSF(WS_GLAS), WSF(WS_GDEC), WSF(WS_LRUP), WSF(WS_LRUE), gid, gsz); PH_END
        __syncthreads();
        PH_BEGIN
          const attn_body::AttnTensors AT{(const attn_body::bf16*)WSB(WS_QP), (const attn_body::bf16*)WSB(WS_KP), (const attn_body::bf16*)(WSB(WS_PROJ) + C_DV), (attn_body::bf16*)WSB(WS_QP)};
          const attn_body::StaticOrder S(G, bx); attn_body::attn_phase<attn_body::StaticOrder>((char*)lds_raw, AT, S);
        PH_END
        grid.sync();
        PH_BEGIN
          pg8::Gemm g{WSB(WS_YS5), WSB(WS_WGLU) + (size_t)l * 65536, T, 256, 256}; pg8::StaticOrder S; S.init(T, 256, G, bx);
          pg8::EpiBf16<0> E{WSB(WS_KP), 256}; pg8::gemm_phase<pg8::EpiBf16<0>, pg8::StaticOrder, true, true>(lds, g, S, E);
        PH_END
        PH_BEGIN for (int u = gw; u < 2048; u += NGW) gla_out_unit(u, WSB(WS_PROJ), in[7] + l * 2048, in[8] + l * 128, in[9] + l * 64, WSF(WS_GLAS), WSB(WS_MIXO), wl, lane); PH_END
        PH_BEGIN phase_lru_out(WSB(WS_PROJ), WSB(WS_LH), WSB(WS_CP), WSF(WS_LRUE), WSB(WS_MIXO), gid, gsz); PH_END
        PH_BEGIN phase_diff_out(l, in, WSB(WS_QP), WSB(WS_MIXO), gid, gsz); PH_END
        grid.sync();
        PH_BEGIN phase_glu_gate(WSB(WS_YS5), WSB(WS_KP), in[24] + l * 256, WSB(WS_MIXO), gid, gsz); PH_END
        grid.sync();
        PH_BEGIN
          pg8::Gemm g{WSB(WS_MIXO), WSB(WS_WOUT) + (size_t)l * DM * DM, T, DM, DM}; pg8::StaticOrder S; S.init(T, DM, G, bx);
          pg8::EpiBf16<0> E{WSB(WS_XF), DM}; pg8::gemm_phase<pg8::EpiBf16<0>, pg8::StaticOrder, true, true>(lds, g, S, E);
        PH_END
        grid.sync();
        PH_BEGIN phase_res_norm((l == 0) ? in[0] : out, out, WSB(WS_XF), in[2] + l * DM, in[3] + l * DM, WSB(WS_XF), gw, NGW, lane); PH_END
        grid.sync();
        PH_BEGIN
          pg8::Gemm g{WSB(WS_XF), WSB(WS_W1) + (size_t)l * DM * DFF, T, DFF, DM}; pg8::StaticOrder S; S.init(T, DFF, G, bx);
          pg8::EpiBf16<2> E{WSB(WS_HID), DFF}; pg8::gemm_phase<pg8::EpiBf16<2>, pg8::StaticOrder, true, true>(lds, g, S, E);
        PH_END
        grid.sync();
        PH_BEGIN
          pg8::Gemm g{WSB(WS_HID), WSB(WS_W2) + (size_t)l * DM * DFF, T, DM, DFF}; pg8::StaticOrder S; S.init(T, DM, G, bx);
          pg8::EpiBf16<0> E{WSB(WS_XF), DM}; pg8::gemm_phase<pg8::EpiBf16<0>, pg8::StaticOrder, true, true>(lds, g, S, E);
        PH_END
        grid.sync();
        PH_BEGIN phase_res_norm(out, out, WSB(WS_XF), in[4] + l * DM, (l + 1 < NLAYER) ? in[1] + (l + 1) * DM : nullptr, WSB(WS_XF), gw, NGW, lane); PH_END
        if (l + 1 < NLAYER) grid.sync();
    }
}

extern "C" void kernel_launch(void* const* d_in, const int* in_sizes, int n_in, void* d_out, int out_size, void* d_ws, size_t ws_size, hipStream_t stream) {
    static int grid = 0;
    if (grid == 0) {
        if (n_in != 34 || in_sizes[0] != T * DM || out_size != T * DM || ws_size < WS_END) { fprintf(stderr, "kernel_launch: unexpected shapes (n_in %d in0 %d out %d ws %zu)\n", n_in, n_in > 0 ? in_sizes[0] : -1, out_size, ws_size); grid = -1; return; }
        int dev = 0, cus = 0, per_cu = 0;
        if (hipGetDevice(&dev) != hipSuccess || hipDeviceGetAttribute(&cus, hipDeviceAttributeMultiprocessorCount, dev) != hipSuccess) { grid = -1; return; }
        if (hipFuncSetAttribute((const void*)fwd_megakernel, hipFuncAttributeMaxDynamicSharedMemorySize, LDS_BYTES) != hipSuccess) { fprintf(stderr, "kernel_launch: hipFuncSetAttribute failed\n"); grid = -1; return; }
        if (hipOccupancyMaxActiveBlocksPerMultiprocessor(&per_cu, (const void*)fwd_megakernel, NWAVES * 64, LDS_BYTES) != hipSuccess || per_cu < 1) { fprintf(stderr, "kernel_launch: occupancy query says %d\n", per_cu); grid = -1; return; }
        grid = cus;
    }
    if (grid < 0) return;
    Args a{};
    for (int i = 0; i < 34; ++i) a.in[i] = (const float*)d_in[i];
    a.out = (float*)d_out; a.ws = (unsigned char*)d_ws;
    void* kargs[] = {&a};
    hipError_t e = hipLaunchCooperativeKernel((const void*)fwd_megakernel, dim3(grid), dim3(NWAVES * 64), kargs, LDS_BYTES, stream);
    if (e != hipSuccess) fprintf(stderr, "kernel_launch: cooperative launch failed: %s (grid %d)\n", hipGetErrorString(e), grid);
}
```

```cpp
#include <hip/hip_runtime.h>
#include <hip/hip_cooperative_groups.h>
#include <cstdio>
#include <cstdint>
namespace cg = cooperative_groups;
#define DUP_MASK 0
namespace pg8 {
#define PG8_LAS __attribute__((address_space(3)))
typedef unsigned short bf16_t;
typedef short bf16x8 __attribute__((ext_vector_type(8)));
typedef float f32x4 __attribute__((ext_vector_type(4)));
typedef unsigned u32x4 __attribute__((ext_vector_type(4)));
constexpr int BM = 256, BK = 64, HALF = 128, HTB = HALF * BK * 2  , STAGE_BYTES = 8 * HTB, NXCD = 8, WGM = 8;

__host__ __device__ __forceinline__ int lds_byte(int r, int c) { const int st = (r >> 4) * 2 + (c >> 5), rr = r & 15, cc = c & 31, ob = rr * 64 + cc * 2; return st * 1024 + (ob ^ (((ob >> 9) & 1) << 5)); }
__host__ __device__ __forceinline__ void stage_rc(int b, int& R, int& C) { const int st = b / 1024, sb = b % 1024, swz = sb ^ (((sb >> 9) & 1) << 5); R = (st >> 1) * 16 + swz / 64; C = (st & 1) * 32 + (swz % 64) / 2; }
__host__ __device__ __forceinline__ int perm32(int rho) { const int n = rho >> 4, i = rho & 15; return 8 * (i >> 2) + 4 * n + (i & 3); }

struct Unit { int pm, pn; };
struct Gemm { const bf16_t* A; const bf16_t* Bt; int M, N, K; };

struct StaticOrder {
    int nM, nN, nwg, G, c;
    __host__ __device__ void init(int M, int N, int G_, int c_) { nM = M / BM; nN = N / BM; nwg = nM * nN; G = G_; c = c_; }
    __host__ __device__ bool next(int i, Unit& u) const {
        const long L = (long)i * G + c; if (L >= nwg) return false;
        int wgid = (int)L; { const int q = nwg / NXCD, r = nwg % NXCD, xcd = wgid % NXCD, off = wgid / NXCD; wgid = (xcd < r ? xcd * (q + 1) : r * (q + 1) + (xcd - r) * q) + off; }
        const int nig = WGM * nN, gid = wgid / nig, fm = gid * WGM, gsz = (nM - fm) < WGM ? (nM - fm) : WGM;
        u.pm = fm + ((wgid % nig) % gsz); u.pn = (wgid % nig) / gsz; return true;
    }
    __device__ __forceinline__ void a_ready(const Unit&) const {}
    __device__ __forceinline__ void done(const Unit&) const {}
};

__device__ __forceinline__ unsigned cvt_pk_bf16(float lo, float hi) { unsigned r; asm volatile("v_cvt_pk_bf16_f32 %0, %1, %2" : "=v"(r) : "v"(lo), "v"(hi)); return r; }
template <int ACT> struct EpiBf16 {
    static constexpr bool PERM = true, AFTER_DRAIN = false;
    bf16_t* O; int ldc;
    __device__ __forceinline__ void operator()(const f32x4 (&acc)[2][2][4][2], const Unit& u, int wr, int wc, int fr, int fq) const {
        const int row0 = u.pm * BM + wr * 64 + fr; const int col0 = u.pn * BM + wc * 32 + 8 * fq;
#pragma unroll
        for (int ai = 0; ai < 2; ++ai)
#pragma unroll
            for (int m = 0; m < 4; ++m) { bf16_t* rowp = O + (size_t)(row0 + ai * HALF + m * 16) * ldc + col0;
#pragma unroll
                for (int bj = 0; bj < 2; ++bj) { f32x4 v0 = acc[ai][bj][m][0], v1 = acc[ai][bj][m][1];
                    if (ACT == 2) {
#pragma unroll
                        for (int e = 0; e < 4; ++e) { float a = v0[e] > 0.f ? v0[e] : 0.f; v0[e] = a * a; float b = v1[e] > 0.f ? v1[e] : 0.f; v1[e] = b * b; } }
                    u32x4 w; w.x = cvt_pk_bf16(v0[0], v0[1]); w.y = cvt_pk_bf16(v0[2], v0[3]); w.z = cvt_pk_bf16(v1[0], v1[1]); w.w = cvt_pk_bf16(v1[2], v1[3]);
                    *(u32x4*)(rowp + bj * HALF) = w; } }
    }
    __device__ __forceinline__ void fused(f32x4 (&)[2][2][4][2], const Unit&, int, int, int, int, PG8_LAS unsigned char*, int, int) const {}
};
struct EpiGlu {
    static constexpr bool PERM = true, AFTER_DRAIN = false;
    const bf16_t* Y_; const float* bias_; bf16_t* O; int ldo, coff;
    __device__ __forceinline__ void operator()(const f32x4 (&acc)[2][2][4][2], const Unit& u, int wr, int wc, int fr, int fq) const {
        const int row0 = u.pm * BM + wr * 64 + fr; const int col0 = u.pn * BM + wc * 32 + 8 * fq;
        const float* bias = bias_; const bf16_t* Y = Y_; asm volatile("" : "+s"(bias), "+s"(Y));
#pragma unroll
        for (int ai = 0; ai < 2; ++ai)
#pragma unroll
            for (int m = 0; m < 4; ++m) { const size_t row = (size_t)(row0 + ai * HALF + m * 16);
#pragma unroll
                for (int bj = 0; bj < 2; ++bj) { const int c = col0 + bj * HALF;
                    const f32x4 v0 = acc[ai][bj][m][0], v1 = acc[ai][bj][m][1];
                    const f32x4 b0 = *(const f32x4*)(bias + c), b1 = *(const f32x4*)(bias + c + 4);
                    const u32x4 yv = *(const u32x4*)(Y + row * 256 + c);
                    float y[8], o[8];
                    y[0] = __uint_as_float(yv.x << 16); y[1] = __uint_as_float(yv.x & 0xffff0000u); y[2] = __uint_as_float(yv.y << 16); y[3] = __uint_as_float(yv.y & 0xffff0000u);
                    y[4] = __uint_as_float(yv.z << 16); y[5] = __uint_as_float(yv.z & 0xffff0000u); y[6] = __uint_as_float(yv.w << 16); y[7] = __uint_as_float(yv.w & 0xffff0000u);
#pragma unroll
                    for (int e = 0; e < 4; ++e) { o[e] = y[e] * __builtin_amdgcn_rcpf(1.f + __expf(-(v0[e] + b0[e]))); o[4 + e] = y[4 + e] * __builtin_amdgcn_rcpf(1.f + __expf(-(v1[e] + b1[e]))); }
                    u32x4 w; w.x = cvt_pk_bf16(o[0], o[1]); w.y = cvt_pk_bf16(o[2], o[3]); w.z = cvt_pk_bf16(o[4], o[5]); w.w = cvt_pk_bf16(o[6], o[7]);
                    *(u32x4*)(O + row * ldo + coff + c) = w; }
                asm volatile("" ::: "memory"); }
    }
    __device__ __forceinline__ void fused(f32x4 (&)[2][2][4][2], const Unit&, int, int, int, int, PG8_LAS unsigned char*, int, int) const {}
};
template <class Epi, class Sched, bool ALIGN_EPI = false, bool SP2 = false>
__device__ __forceinline__ void gemm_phase(PG8_LAS unsigned char* lds, const Gemm g, const Sched& S, const Epi& E) {
    int tid_l = threadIdx.x; asm volatile("" : "+v"(tid_l));
    const int tid = tid_l, wid = __builtin_amdgcn_readfirstlane(tid >> 6), lane = tid & 63, wr = wid >> 2, wc = wid & 3, fr = lane & 15, fq = lane >> 4;
    const int K = g.K, nt = K / BK;
    unsigned voffA[2], voffB[2];
#pragma unroll
    for (int i = 0; i < 2; ++i) { int R, C; stage_rc(tid * 16 + i * 8192, R, C); const int Rb = Epi::PERM ? ((R & ~31) + perm32(R & 31)) : R;
        voffA[i] = (unsigned)(R * K + C) * 2u; voffB[i] = (unsigned)(Rb * K + C) * 2u; }
    const size_t kstep = (size_t)(BK * 2);
    const size_t hstep = (size_t)HALF * K * 2;
    const size_t tstep = 2 * hstep;
    const unsigned ldsw = (unsigned)wid * 1024u;
    const int aoff = lds_byte(wr * 64 + fr, fq * 8), boff = lds_byte(wc * 32 + fr, fq * 8);
#define PG8_SA(b, h) (((b) * 2 + (h)) * HTB)
#define PG8_SB(b, h) ((4 + (b) * 2 + (h)) * HTB)
#define PG8_STAGE(bufoff, gbase, voff) do { _Pragma("unroll") for (int _i = 0; _i < 2; ++_i) \
        __builtin_amdgcn_global_load_lds((const unsigned*)((const char*)(gbase) + (voff)[_i]), (PG8_LAS unsigned*)(lds + (bufoff) + ldsw + _i * 8192), 16, 0, 0); } while (0)
#define PG8_LDA(dst, b, h) do { _Pragma("unroll") for (int m = 0; m < 4; ++m) _Pragma("unroll") for (int k = 0; k < 2; ++k) dst[m][k] = *(const PG8_LAS bf16x8*)(lds + PG8_SA(b, h) + aoff + m * 2048 + k * 1024); } while (0)
#define PG8_LDB(dst, b, h) do { _Pragma("unroll") for (int n = 0; n < 2; ++n) _Pragma("unroll") for (int k = 0; k < 2; ++k) dst[n][k] = *(const PG8_LAS bf16x8*)(lds + PG8_SB(b, h) + boff + n * 2048 + k * 1024); } while (0)
#define PG8_MMA(ai, bj, At, Bt) do { __builtin_amdgcn_s_setprio(1); _Pragma("unroll") for (int m = 0; m < 4; ++m) _Pragma("unroll") for (int n = 0; n < 2; ++n) _Pragma("unroll") for (int k = 0; k < 2; ++k) \
        acc[ai][bj][m][n] = __builtin_amdgcn_mfma_f32_16x16x32_bf16(Bt[n][k], At[m][k], acc[ai][bj][m][n], 0, 0, 0); __builtin_amdgcn_s_setprio(0); } while (0)
#define PG8_WAIT_V(n) asm volatile("s_waitcnt vmcnt(" #n ")" ::: "memory")
#define PG8_WAIT_L(n) asm volatile("s_waitcnt lgkmcnt(" #n ")" ::: "memory")
#define PG8_BAR __builtin_amdgcn_s_barrier()
#define PG8_SCHED __builtin_amdgcn_sched_barrier(0)
    Unit cur, nxt; int ui = 0;
    if (!S.next(0, cur)) return;
    f32x4 acc[2][2][4][2];
#pragma unroll
    for (int a = 0; a < 2; ++a)
#pragma unroll
        for (int b = 0; b < 2; ++b)
#pragma unroll
            for (int m = 0; m < 4; ++m)
#pragma unroll
                for (int n = 0; n < 2; ++n) acc[a][b][m][n] = (f32x4){0.f, 0.f, 0.f, 0.f};
    bf16x8 At[4][2], B0[2][2], B1[2][2];
    const char* cA = (const char*)g.A + (size_t)cur.pm * tstep; const char* cB = (const char*)g.Bt + (size_t)cur.pn * tstep;
    S.a_ready(cur);
    if constexpr (SP2) {
        PG8_STAGE(PG8_SB(0, 0), cB, voffB); PG8_STAGE(PG8_SB(0, 1), cB + hstep, voffB); PG8_STAGE(PG8_SA(0, 0), cA, voffA); PG8_STAGE(PG8_SA(0, 1), cA + hstep, voffA);
        if (wr == 1) PG8_BAR;
        PG8_WAIT_V(2); PG8_BAR;
        PG8_STAGE(PG8_SB(1, 0), cB + kstep, voffB); PG8_STAGE(PG8_SA(1, 0), cA + kstep, voffA); PG8_STAGE(PG8_SB(1, 1), cB + hstep + kstep, voffB);
        PG8_WAIT_V(6); PG8_BAR;
    } else {
        PG8_STAGE(PG8_SB(0, 0), cB, voffB); PG8_STAGE(PG8_SA(0, 0), cA, voffA); PG8_STAGE(PG8_SB(0, 1), cB + hstep, voffB); PG8_STAGE(PG8_SA(0, 1), cA + hstep, voffA);
        if (wr == 1) PG8_BAR;
        PG8_WAIT_V(4); PG8_BAR;
        PG8_STAGE(PG8_SB(1, 0), cB + kstep, voffB); PG8_STAGE(PG8_SA(1, 0), cA + kstep, voffA); PG8_STAGE(PG8_SB(1, 1), cB + hstep + kstep, voffB);
        PG8_WAIT_V(6); PG8_BAR;
    }
    for (;;) {
        const bool has_next = S.next(ui + 1, nxt);
        const char* nA = has_next ? (const char*)g.A + (size_t)nxt.pm * tstep : cA; const char* nB = has_next ? (const char*)g.Bt + (size_t)nxt.pn * tstep : cB;
        for (int t = 0; t < nt; t += 2) {
            const bool last = (t == nt - 2);
            const char* a1 = cA + (size_t)(t + 1) * kstep;
            const char* a2 = last ? nA : cA + (size_t)(t + 2) * kstep; const char* b2 = last ? nB : cB + (size_t)(t + 2) * kstep;
            const char* a3 = a2 + kstep; const char* b3 = b2 + kstep;
            if (last && has_next) S.a_ready(nxt);
            if constexpr (SP2) {
            PG8_LDB(B0, 0, 0); PG8_LDB(B1, 0, 1); PG8_SCHED; PG8_LDA(At, 0, 0); PG8_STAGE(PG8_SA(1, 1), a1 + hstep, voffA);
            PG8_WAIT_V(8); PG8_WAIT_L(0); PG8_BAR; PG8_MMA(0, 0, At, B0); PG8_MMA(0, 1, At, B1); PG8_BAR; PG8_SCHED;
            PG8_LDA(At, 0, 1); PG8_STAGE(PG8_SB(0, 0), b2, voffB); PG8_STAGE(PG8_SB(0, 1), b2 + hstep, voffB); PG8_STAGE(PG8_SA(0, 0), a2, voffA);
            PG8_WAIT_V(8); PG8_WAIT_L(0); PG8_BAR; PG8_MMA(1, 0, At, B0); PG8_MMA(1, 1, At, B1); PG8_BAR; PG8_SCHED;
            PG8_LDB(B0, 1, 0); PG8_LDB(B1, 1, 1); PG8_SCHED; PG8_LDA(At, 1, 0); PG8_STAGE(PG8_SA(0, 1), a2 + hstep, voffA);
            PG8_WAIT_V(8); PG8_WAIT_L(0); PG8_BAR; PG8_MMA(0, 0, At, B0); PG8_MMA(0, 1, At, B1); PG8_BAR; PG8_SCHED;
            PG8_LDA(At, 1, 1); PG8_STAGE(PG8_SB(1, 0), b3, voffB); PG8_STAGE(PG8_SB(1, 1), b3 + hstep, voffB); PG8_STAGE(PG8_SA(1, 0), a3, voffA);
            PG8_WAIT_V(8); PG8_WAIT_L(0); PG8_BAR; PG8_MMA(1, 0, At, B0); PG8_MMA(1, 1, At, B1); PG8_BAR; PG8_SCHED;
            } else {
            PG8_LDB(B0, 0, 0); PG8_SCHED; PG8_LDA(At, 0, 0); PG8_STAGE(PG8_SA(1, 1), a1 + hstep, voffA);
            PG8_WAIT_L(8); PG8_BAR; PG8_WAIT_L(0); PG8_MMA(0, 0, At, B0); PG8_BAR; PG8_SCHED;
            PG8_LDB(B1, 0, 1); PG8_STAGE(PG8_SB(0, 0), b2, voffB);
            PG8_BAR; PG8_WAIT_L(0); PG8_MMA(0, 1, At, B1); PG8_BAR;
            PG8_LDA(At, 0, 1); PG8_STAGE(PG8_SA(0, 0), a2, voffA);
            PG8_BAR; PG8_WAIT_L(0); PG8_MMA(1, 0, At, B0); PG8_BAR; PG8_SCHED;
            PG8_STAGE(PG8_SB(0, 1), b2 + hstep, voffB);
            PG8_WAIT_V(6); PG8_BAR; PG8_MMA(1, 1, At, B1); PG8_BAR;
            PG8_LDB(B0, 1, 0); PG8_SCHED; PG8_LDA(At, 1, 0); PG8_STAGE(PG8_SA(0, 1), a2 + hstep, voffA);
            PG8_WAIT_L(8); PG8_BAR; PG8_WAIT_L(0); PG8_MMA(0, 0, At, B0); PG8_BAR; PG8_SCHED;
            PG8_LDB(B1, 1, 1); PG8_STAGE(PG8_SB(1, 0), b3, voffB);
            PG8_BAR; PG8_WAIT_L(0); PG8_MMA(0, 1, At, B1); PG8_BAR;
            PG8_LDA(At, 1, 1); PG8_STAGE(PG8_SA(1, 0), a3, voffA);
            PG8_BAR; PG8_WAIT_L(0); PG8_MMA(1, 0, At, B0); PG8_BAR; PG8_SCHED;
            PG8_STAGE(PG8_SB(1, 1), b3 + hstep, voffB);
            PG8_WAIT_V(6); PG8_BAR; PG8_MMA(1, 1, At, B1); PG8_BAR;
            }
        }
        if constexpr (ALIGN_EPI) { if (wr == 0) PG8_BAR; }
        if constexpr (!Epi::AFTER_DRAIN) { E(acc, cur, wr, wc, fr, fq); S.done(cur); }
        if (!has_next) break;
#pragma unroll
        for (int a = 0; a < 2; ++a)
#pragma unroll
            for (int b = 0; b < 2; ++b)
#pragma unroll
                for (int m = 0; m < 4; ++m)
#pragma unroll
                    for (int n = 0; n < 2; ++n) acc[a][b][m][n] = (f32x4){0.f, 0.f, 0.f, 0.f};
        cur = nxt; cA = nA; cB = nB; ++ui;
        if constexpr (ALIGN_EPI) { if (wr == 1) PG8_BAR; }
    }
    PG8_WAIT_V(0);
    if constexpr (!ALIGN_EPI) { if (wr == 0) PG8_BAR; }
    PG8_BAR;
    if constexpr (Epi::AFTER_DRAIN) { E.fused(acc, cur, wr, wc, fr, fq, lds, wid, lane); S.done(cur); }
#undef PG8_SA
#undef PG8_SB
#undef PG8_STAGE
#undef PG8_LDA
#undef PG8_LDB
#undef PG8_MMA
#undef PG8_WAIT_V
#undef PG8_WAIT_L
#undef PG8_BAR
#undef PG8_SCHED
}
}
#include <hip/hip_bf16.h>
#include <cmath>
namespace attn_body {
using bf16=__hip_bfloat16;
using bf16x8=__attribute__((ext_vector_type(8)))short;
using s16x4=__attribute__((ext_vector_type(4)))short;
using f32x16=__attribute__((ext_vector_type(16)))float;
using u32x4=__attribute__((ext_vector_type(4)))unsigned;
constexpr int BATCH=8,NHEAD=8,SEQ=4096,D=64,PQ=512,PV=2560;
constexpr int NW=8,QBLK=32,QB=QBLK*NW,KVBLK=64,NQB=SEQ/QB;
constexpr int ATTN_UNIT_ROWS=QB;
__device__ __forceinline__ int crow(int r,int hi){return (r&3)+8*(r>>2)+4*hi;}
#define SBAR() __builtin_amdgcn_sched_barrier(0)
__device__ __forceinline__ void cmask(f32x16&p0,f32x16&p1,int jb,int qrel,int hi){
  const float NEG=-INFINITY; int kb=64*jb+4*hi;
  #pragma unroll
  for(int r=0;r<16;++r){int kv=kb+(r&3)+8*(r>>2); if(kv>qrel)p0[r]=NEG; if(kv+32>qrel)p1[r]=NEG;}
}

constexpr int NSLOT=3, SLOTB=8192;
constexpr int LDS_K=0, LDS_V=NSLOT*SLOTB, LDS_WS=2*NSLOT*SLOTB, LDS_OST=LDS_WS+NW*64*4, LDS_BYTES=LDS_OST+NW*4096;
constexpr float C2=0.17677669529663687f*1.4426950408889634f;
__device__ __forceinline__ void glds16(const void*gsrc,unsigned lds_dst){unsigned keep;
  asm volatile("s_mov_b32 %0, m0\n\ts_mov_b32 m0, %2\n\ts_nop 0\n\tglobal_load_lds_dwordx4 %1, off\n\ts_mov_b32 m0, %0":"=&s"(keep):"v"(gsrc),"s"(lds_dst):"memory");}
__device__ __forceinline__ float max3f(float a,float b,float c){float r;asm("v_max3_f32 %0, %1, %2, %3":"=v"(r):"v"(a),"v"(b),"v"(c));return r;}
__device__ __forceinline__ float max2f(float a,float b){float r;asm("v_max_f32_e32 %0, %1, %2":"=v"(r):"v"(a),"v"(b));return r;}
__device__ __forceinline__ float fadd_s(float a,float b){float r;asm("v_add_f32_e32 %0, %1, %2":"=v"(r):"v"(a),"v"(b));return r;}
__device__ __forceinline__ float fsub_s(float a,float b){float r;asm("v_sub_f32_e32 %0, %1, %2":"=v"(r):"v"(a),"v"(b));return r;}
typedef float f32x2_t __attribute__((ext_vector_type(2))); typedef __bf16 bf16x2_t __attribute__((ext_vector_type(2)));
__device__ __forceinline__ unsigned cvtpk_s(float lo,float hi){f32x2_t v={lo,hi};bf16x2_t b=__builtin_convertvector(v,bf16x2_t);return __builtin_bit_cast(unsigned,b);}
#define WAIT_BAR(N) asm volatile("s_waitcnt vmcnt(" #N ") lgkmcnt(0)\n\ts_barrier":::"memory")

__device__ __forceinline__ void qkt(f32x16&p0,f32x16&p1,const char*Kslot,const bf16x8*qr,const f32x16&negm,int r32,int hi){
  const char*kb=Kslot+hi*1024+r32*16;
  #pragma unroll
  for(int d0=0;d0<2;++d0){
    const bf16x8 b0=*reinterpret_cast<const bf16x8*>(kb+d0*2048);
    const bf16x8 b1=*reinterpret_cast<const bf16x8*>(kb+d0*2048+512);
    if(d0==0){p0=__builtin_amdgcn_mfma_f32_32x32x16_bf16(b0,qr[0],negm,0,0,0);p1=__builtin_amdgcn_mfma_f32_32x32x16_bf16(b1,qr[0],negm,0,0,0);}
    else{p0=__builtin_amdgcn_mfma_f32_32x32x16_bf16(b0,qr[d0],p0,0,0,0);p1=__builtin_amdgcn_mfma_f32_32x32x16_bf16(b1,qr[d0],p1,0,0,0);}}
}
typedef __attribute__((address_space(3))) const char* lds_cptr;
typedef short v4i16_t __attribute__((ext_vector_type(4)));
__device__ __forceinline__ void kload8(bf16x8*kf,lds_cptr kp){
  kf[0]=*(const __attribute__((address_space(3))) bf16x8*)(kp);      kf[1]=*(const __attribute__((address_space(3))) bf16x8*)(kp+512);
  kf[2]=*(const __attribute__((address_space(3))) bf16x8*)(kp+2048); kf[3]=*(const __attribute__((address_space(3))) bf16x8*)(kp+2560);
}
__device__ __forceinline__ void kload2(bf16x8*kf,lds_cptr kp,int j){ kf[2*j]=*(const __attribute__((address_space(3))) bf16x8*)(kp+j*2048); kf[2*j+1]=*(const __attribute__((address_space(3))) bf16x8*)(kp+j*2048+512); }
__device__ __forceinline__ s16x4 vtr(lds_cptr p){ return __builtin_bit_cast(s16x4,__builtin_amdgcn_ds_read_tr16_b64_v4i16((__attribute__((address_space(3))) v4i16_t*)p)); }
__device__ __forceinline__ float rowmax(const f32x16&p0,const f32x16&p1){
  float a=max3f(p0[0],p0[1],p1[0]),b=max3f(p0[2],p0[3],p1[1]);a=max3f(a,p1[2],p1[3]);
  #pragma unroll
  for(int r=4;r<16;r+=4){a=max3f(a,p0[r],p0[r+1]);b=max3f(b,p0[r+2],p0[r+3]);a=max3f(a,p1[r],p1[r+1]);b=max3f(b,p1[r+2],p1[r+3]);}
  const float m=max2f(a,b);
  auto rr=__builtin_amdgcn_permlane32_swap(__float_as_uint(m),__float_as_uint(m),false,false);
  return max2f(__uint_as_float(rr[0]),__uint_as_float(rr[1]));
}
__device__ __forceinline__ void pv(f32x16*o,int vb,bf16x8 pa0,bf16x8 pa1,bf16x8 pa2,bf16x8 pa3){
  #pragma unroll
  for(int d0=0;d0<2;++d0){s16x4 lo[4],hi[4];
    #pragma unroll
    for(int ks=0;ks<4;++ks){
      asm volatile("ds_read_b64_tr_b16 %0,%1 offset:%c2":"=&v"(lo[ks]):"v"(vb),"i"(d0*4096+ks*1024):"memory");
      asm volatile("ds_read_b64_tr_b16 %0,%1 offset:%c2":"=&v"(hi[ks]):"v"(vb),"i"(d0*4096+ks*1024+512):"memory");}
    asm volatile("s_waitcnt lgkmcnt(0)":::"memory");SBAR();
    #define PK(k) (bf16x8){lo[k][0],lo[k][1],lo[k][2],lo[k][3],hi[k][0],hi[k][1],hi[k][2],hi[k][3]}
    o[d0]=__builtin_amdgcn_mfma_f32_32x32x16_bf16(pa0,PK(0),o[d0],0,0,0);
    o[d0]=__builtin_amdgcn_mfma_f32_32x32x16_bf16(pa1,PK(1),o[d0],0,0,0);
    o[d0]=__builtin_amdgcn_mfma_f32_32x32x16_bf16(pa2,PK(2),o[d0],0,0,0);
    o[d0]=__builtin_amdgcn_mfma_f32_32x32x16_bf16(pa3,PK(3),o[d0],0,0,0);
    #undef PK
  }
}

#ifndef ATTN_STORE16
#define ATTN_STORE16(p,v) (*(u32x4*)(p)=(v))
#endif
template<int THRL> __device__ __forceinline__ void attn_unit(int b,int h,int qb,const bf16*Q,const bf16*__restrict__ K,const bf16*__restrict__ V,bf16*O,char*shm){
  int tid_l=threadIdx.x; asm volatile("":"+v"(tid_l));
  const int tid=tid_l,lane=tid&63,r32=lane&31,hi=lane>>5; const int wid=__builtin_amdgcn_readfirstlane(tid>>6);
  const long rowbase=(long)b*SEQ; const int q0=qb*QB;
  const bf16*Qw=Q+(rowbase+q0+wid*QBLK)*PQ+h*D;
  const bf16*Kh=K+rowbase*PQ+h*D,*Vh=V+rowbase*PV+(h>>1)*D;
  const unsigned lds0=(unsigned)(uintptr_t)shm;
  float*wsf=(float*)(shm+LDS_WS)+wid*64;
  const bf16*ksrc=Kh+(long)lane*PQ+wid*8;
  const bf16*vsrc=Vh+(long)(16*(wid&3)+(lane>>2))*PV+(wid>>2)*32+(lane&3)*8;
  const unsigned kdst=lds0+LDS_K+wid*1024, vdst=lds0+LDS_V+wid*1024;
  #define DMA_K(t,slot) glds16(ksrc+(long)(t)*KVBLK*PQ,(unsigned)__builtin_amdgcn_readfirstlane(kdst+(slot)))
  #define DMA_V(t,slot) glds16(vsrc+(long)(t)*KVBLK*PV,(unsigned)__builtin_amdgcn_readfirstlane(vdst+(slot)))
  const int vb0=(int)(lds0+LDS_V)+((lane>>4)&1)*32+(lane&3)*8+(4*hi+((lane&15)>>2))*64;
  const char*Kbase=shm+LDS_K; bf16x8 kf[8];
  const lds_cptr shm3=(lds_cptr)shm; const lds_cptr kp0=shm3+LDS_K+hi*1024+r32*16; const lds_cptr vp0=shm3+LDS_V+((lane>>4)&1)*32+(lane&3)*8+(4*hi+((lane&15)>>2))*64;
  const int NT=(q0+QB)/KVBLK;
  DMA_K(0,0);DMA_V(0,0);DMA_K(1,SLOTB);
  bf16x8 qr[4];
  #pragma unroll
  for(int d0=0;d0<2;++d0)qr[d0]=*reinterpret_cast<const bf16x8*>(&Qw[(long)r32*PQ+d0*16+hi*8]);
  float mhat=0.f,l_reg=0.f;f32x16 o[2];o[0]=f32x16{};o[1]=f32x16{};f32x16 negm=f32x16{};asm volatile("":"+v"(negm));
  const int qrel=wid*QBLK+r32;
  #define CMASK(P0,P1,t) do{int jb_=(t)-(NT-4); if(jb_>=0)cmask(P0,P1,jb_,qrel,hi);}while(0)
  bool resc=false;
  #define START(P0,P1) do{ const float rm=rowmax(P0,P1); resc=false; \
    { const float dl=rm; mhat=fadd_s(mhat,dl); \
      _Pragma("unroll") for(int r=0;r<16;++r){P0[r]=fsub_s(P0[r],dl);P1[r]=fsub_s(P1[r],dl);} \
      _Pragma("unroll") for(int r=0;r<16;++r)negm[r]=-mhat; asm volatile("":"+v"(negm)); } \
    _Pragma("unroll") for(int r=0;r<16;++r)P0[r]=__builtin_amdgcn_exp2f(P0[r]); }while(0)
  #define RESC() do{ if(resc){ asm volatile("s_waitcnt lgkmcnt(0)":::"memory"); \
      _Pragma("unroll") for(int d_=0;d_<2;++d_) _Pragma("unroll") for(int r=0;r<16;++r)o[d_][r]*=wsf[crow(r,hi)]; } }while(0)
  f32x16 pA0,pA1,pB0,pB1;
  int sl_prev=0,sl_cur=0,sl_next=SLOTB;
  #define ROT() do{sl_prev=sl_cur;sl_cur=sl_next;sl_next=(sl_next==(NSLOT-1)*SLOTB)?0:sl_next+SLOTB;}while(0)
  DMA_K(2,2*SLOTB);
  WAIT_BAR(3);
  qkt(pA0,pA1,Kbase,qr,negm,r32,hi);asm volatile("s_nop 15\n\ts_nop 7":"+v"(pA0),"+v"(pA1));CMASK(pA0,pA1,0);
  START(pA0,pA1);
  _Pragma("unroll") for(int r=0;r<16;++r)pA1[r]=__builtin_amdgcn_exp2f(pA1[r]);
  WAIT_BAR(0);
  DMA_K(3,0);DMA_V(1,SLOTB);
  ROT();
  kload8(kf,kp0+sl_cur);
  WAIT_BAR(2);
  s16x4 vlo[8],vhi[8]; u32x4 pw0,pw1,pw2,pw3;
  #define PKW(P,B) cvtpk_s(P[B],P[B+1])
  #define PAF(k) __builtin_bit_cast(bf16x8,pw##k)
  #define VFR(i) (bf16x8){vlo[i][0],vlo[i][1],vlo[i][2],vlo[i][3],vhi[i][0],vhi[i][1],vhi[i][2],vhi[i][3]}
  #define PIN(x) asm volatile("":"+v"(x))
  #define MX3(a,b,c) __builtin_fmaxf(__builtin_fmaxf((a),(b)),(c))
  #define GAPA(MF,A0,A1,A2,A3,W0,W1,PW) do{ MF; sacc+=A0; sacc+=A1; sacc+=A2; sacc+=A3; PIN(sacc); W0; W1; PIN(PW); SBAR(); }while(0)
  #define EX(v) __builtin_amdgcn_exp2f(v)
  #define GAPB(MF,X,B) do{ MF; X[B]=EX(X[B]); X[B+1]=EX(X[B+1]); X[B+2]=EX(X[B+2]); X[B+3]=EX(X[B+3]); PIN(X); SBAR(); }while(0)
  #define VRD(i) do{ vlo[i]=vtr(vp_+(((i)>>2)*4096+((i)&3)*1024)); vhi[i]=vtr(vp_+(((i)>>2)*4096+((i)&3)*1024+512)); }while(0)
  #define KRD(G,j) do{ if(G){ kload2(kf,kp0+sl_next,j); SBAR(); } }while(0)
  #define STEP(C0,C1,P0,P1,t,GK,GV,GL) do{ SBAR(); \
    const lds_cptr vp_=vp0+sl_prev; \
    VRD(0); SBAR(); float sacc=(P0[0]+P0[1]); \
    GAPA(C0=__builtin_amdgcn_mfma_f32_32x32x16_bf16(kf[0],qr[0],negm,0,0,0), P0[2],P0[3],P0[4],P0[5],     pw0[0]=PKW(P0,0), pw0[1]=PKW(P0,2), pw0); \
    VRD(4); SBAR(); GAPA(C1=__builtin_amdgcn_mfma_f32_32x32x16_bf16(kf[1],qr[0],negm,0,0,0), P0[6],P0[7],P0[8],P0[9],     pw0[2]=PKW(P0,4), pw0[3]=PKW(P0,6), pw0); \
    VRD(1); SBAR(); GAPA(C0=__builtin_amdgcn_mfma_f32_32x32x16_bf16(kf[2],qr[1],C0,0,0,0),   P0[10],P0[11],P0[12],P0[13], pw1[0]=PKW(P0,8), pw1[1]=PKW(P0,10), pw1); \
    VRD(5); SBAR(); GAPA(C1=__builtin_amdgcn_mfma_f32_32x32x16_bf16(kf[3],qr[1],C1,0,0,0),   P0[14],P0[15],P1[0],P1[1],   pw1[2]=PKW(P0,12),pw1[3]=PKW(P0,14), pw1); \
    VRD(2); SBAR(); GAPA((void)0,   P1[2],P1[3],P1[4],P1[5],     pw2[0]=PKW(P1,0), pw2[1]=PKW(P1,2), pw2); \
    VRD(6); SBAR(); GAPA((void)0,   P1[6],P1[7],P1[8],P1[9],     pw2[2]=PKW(P1,4), pw2[3]=PKW(P1,6), pw2); \
    VRD(3); SBAR(); GAPA((void)0,   P1[10],P1[11],P1[12],P1[13], pw3[0]=PKW(P1,8), pw3[1]=PKW(P1,10), pw3); \
    VRD(7); SBAR(); GAPA((void)0,   P1[14],P1[15],0.f,0.f,       pw3[2]=PKW(P1,12),pw3[3]=PKW(P1,14), pw3); \
    l_reg+=sacc; \
    if(GK){DMA_K((t)+3,sl_cur);} if(GV){DMA_V((t)+1,sl_next);} \
    CMASK(C0,C1,t); \
    { float a=MX3(C0[0],C0[1],C1[0]),b=MX3(C0[2],C0[3],C1[1]); a=MX3(a,C1[2],C1[3]); \
      _Pragma("unroll") for(int r=4;r<16;r+=4){a=MX3(a,C0[r],C0[r+1]);b=MX3(b,C0[r+2],C0[r+3]);a=MX3(a,C1[r],C1[r+1]);b=MX3(b,C1[r+2],C1[r+3]);} \
      float rm=__builtin_fmaxf(a,b); { auto rr=__builtin_amdgcn_permlane32_swap(__float_as_uint(rm),__float_as_uint(rm),false,false); rm=__builtin_fmaxf(__uint_as_float(rr[0]),__uint_as_float(rr[1])); } \
      resc=false; \
      if(__builtin_expect(__any(rm>(float)THRL),0)){ const float dl=__builtin_fmaxf(rm,0.f); mhat+=dl; \
        _Pragma("unroll") for(int r=0;r<16;++r){C0[r]-=dl;C1[r]-=dl;} \
        _Pragma("unroll") for(int r=0;r<16;++r)negm[r]=-mhat; asm volatile("":"+v"(negm)); \
        const float f=__builtin_amdgcn_exp2f(-dl); l_reg*=f; if(hi==0)wsf[r32]=f; resc=true; } } \
    SBAR(); \
    GAPB(o[0]=__builtin_amdgcn_mfma_f32_32x32x16_bf16(PAF(0),VFR(0),o[0],0,0,0), C0,0); \
    GAPB(o[1]=__builtin_amdgcn_mfma_f32_32x32x16_bf16(PAF(0),VFR(4),o[1],0,0,0), C0,4); \
    KRD(GL,0); GAPB(o[0]=__builtin_amdgcn_mfma_f32_32x32x16_bf16(PAF(1),VFR(1),o[0],0,0,0), C0,8); \
    KRD(GL,1); GAPB(o[1]=__builtin_amdgcn_mfma_f32_32x32x16_bf16(PAF(1),VFR(5),o[1],0,0,0), C0,12); \
    GAPB(o[0]=__builtin_amdgcn_mfma_f32_32x32x16_bf16(PAF(2),VFR(2),o[0],0,0,0), C1,0); \
    GAPB(o[1]=__builtin_amdgcn_mfma_f32_32x32x16_bf16(PAF(2),VFR(6),o[1],0,0,0), C1,4); \
    GAPB(o[0]=__builtin_amdgcn_mfma_f32_32x32x16_bf16(PAF(3),VFR(3),o[0],0,0,0), C1,8); \
    GAPB(o[1]=__builtin_amdgcn_mfma_f32_32x32x16_bf16(PAF(3),VFR(7),o[1],0,0,0), C1,12); \
    }while(0)
  int t=1;
  #undef CMASK
  #define CMASK(P0,P1,t) do{}while(0)
  for(;t+5<NT;t+=2){
    STEP(pB0,pB1,pA0,pA1,t,true,true,true);     WAIT_BAR(2); RESC(); ROT();
    STEP(pA0,pA1,pB0,pB1,t+1,true,true,true);   WAIT_BAR(2); RESC(); ROT();
  }
  #undef CMASK
  #define CMASK(P0,P1,t) do{int jb_=(t)-(NT-4); if(jb_>=0)cmask(P0,P1,jb_,qrel,hi);}while(0)
  #define ENDW(tt) do{ if((tt)+3<NT){WAIT_BAR(2);} else if((tt)+2<NT){WAIT_BAR(1);} else {WAIT_BAR(0);} }while(0)
  for(;t+1<NT;t+=2){
    STEP(pB0,pB1,pA0,pA1,t,(t+3<NT),(t+1<NT),(t+1<NT));       ENDW(t);   RESC(); ROT();
    STEP(pA0,pA1,pB0,pB1,t+1,(t+4<NT),(t+2<NT),(t+2<NT));     ENDW(t+1); RESC(); ROT();
  }
  STEP(pB0,pB1,pA0,pA1,NT-1,false,false,false); RESC();
  { float sacc=pB0[0]+pB0[1]; _Pragma("unroll") for(int r=2;r<16;++r)sacc+=pB0[r]; _Pragma("unroll") for(int r=0;r<16;++r)sacc+=pB1[r]; l_reg+=sacc;
    pw0=(u32x4){PKW(pB0,0),PKW(pB0,2),PKW(pB0,4),PKW(pB0,6)};pw1=(u32x4){PKW(pB0,8),PKW(pB0,10),PKW(pB0,12),PKW(pB0,14)};pw2=(u32x4){PKW(pB1,0),PKW(pB1,2),PKW(pB1,4),PKW(pB1,6)};pw3=(u32x4){PKW(pB1,8),PKW(pB1,10),PKW(pB1,12),PKW(pB1,14)};
    SBAR(); pv(o,vb0+sl_cur,PAF(0),PAF(1),PAF(2),PAF(3)); }
  #undef PKW
  #undef PAF
  #undef VFR
  #undef PIN
  #undef MX3
  #undef GAPA
  #undef GAPB
  #undef EX
  #undef VRD
  #undef KRD
  #undef STEP
  #undef ENDW
  {auto rr=__builtin_amdgcn_permlane32_swap(__float_as_uint(l_reg),__float_as_uint(l_reg),false,false);l_reg=__uint_as_float(rr[0])+__uint_as_float(rr[1]);}
  if(hi==0)wsf[32+r32]=l_reg;asm volatile("s_waitcnt lgkmcnt(0)":::"memory");
  float rli[16];
  #pragma unroll
  for(int r=0;r<16;++r)rli[r]=__builtin_amdgcn_rcpf(wsf[32+crow(r,hi)]);
  bf16*Ow=O+(rowbase+q0+wid*QBLK)*PQ+h*D;
  { bf16*stg=(bf16*)(shm+LDS_OST)+wid*2048;
    #pragma unroll
    for(int r=0;r<16;++r){const int orow=crow(r,hi);
      #pragma unroll
      for(int d0=0;d0<2;++d0)stg[orow*64+d0*32+r32]=__float2bfloat16(o[d0][r]*rli[r]);}
    asm volatile("s_waitcnt lgkmcnt(0)":::"memory");
    #pragma unroll
    for(int i=0;i<4;++i){const int row=i*8+(lane>>3),ch=lane&7; const u32x4 v=*(const u32x4*)(stg+row*64+ch*8); ATTN_STORE16(Ow+(long)row*PQ+ch*8,v);} }
  asm volatile("s_waitcnt lgkmcnt(0)\n\ts_barrier":::"memory");
  #undef DMA_K
  #undef DMA_V
  #undef CMASK
  #undef START
  #undef RESC
  #undef ROT
}
constexpr int ATTN_LDS_BYTES=LDS_BYTES;
struct AttnTensors { const bf16* Q; const bf16* K; const bf16* V; bf16* O; };
struct AttnUnit { int bh; int qb; };
struct StaticOrder {
  int vcu,G;
  __device__ __forceinline__ explicit StaticOrder(int grid,int block):vcu((grid%8==0)?(block%8)*(grid/8)+block/8:block),G(grid){}
  __device__ __forceinline__ bool next(int i,AttnUnit&u)const{
    if(G==256){ if(i>=4)return false; const int s=vcu&3; u.bh=vcu>>2; u.qb=(i==0)?s:(i==1)?7-s:(i==2)?8+s:15-s; return true; }
    const int L=i*G+vcu; if(L>=BATCH*NHEAD*NQB)return false; u.bh=L/NQB; u.qb=NQB-1-(L%NQB); return true; }
  __device__ __forceinline__ void a_ready(const AttnUnit&)const{}
  __device__ __forceinline__ void done(const AttnUnit&)const{}
};
template<class Sched,int THRL=8> __device__ __forceinline__ void attn_phase(char*lds,const AttnTensors&T,const Sched&S){
  AttnUnit u;
  for(int i=0;S.next(i,u);++i){ S.a_ready(u); attn_unit<THRL>(u.bh/NHEAD,u.bh%NHEAD,u.qb,T.Q,T.K,T.V,T.O,lds); S.done(u); }
}
#undef SBAR
#undef WAIT_BAR
}
#define LAS __attribute__((address_space(3)))
typedef unsigned short bf16;
typedef float f32x4 __attribute__((ext_vector_type(4)));
typedef unsigned u32x4 __attribute__((ext_vector_type(4)));
typedef unsigned u32x2 __attribute__((ext_vector_type(2)));
constexpr int NB = 8, SEQ = 4096, T = NB * SEQ, DM = 1024, DFF = 4096, PP = 2560, NLAYER = 2, NWAVES = 8;
constexpr float EPS = 1e-6f;
constexpr int C_GQ = 0, C_GK = 128, C_GV = 256, C_GOG = 512, C_DQ = 768, C_DK = 1024, C_DV = 1280, C_SU = 1536, C_RX = 1792, C_RG = 2048, C_GLR = 2304;
__host__ __device__ __forceinline__ int win_src_col(int c) { return c < 512 ? c : (c < 2304 ? c + 16 : (c < 2320 ? 512 + (c - 2304) : -1)); }
constexpr size_t MiB = 1u << 20;
constexpr size_t WS_ROPE = 1 * MiB;
constexpr size_t WS_S5E = 2 * MiB;
constexpr size_t WS_LRUP = 3 * MiB;
constexpr size_t WS_LRUE = WS_LRUP + 512 * 1024;
constexpr size_t WS_GDEC = 4 * MiB;
constexpr size_t WS_WGLU = 5 * MiB;
constexpr size_t WS_WIN = 8 * MiB;
constexpr size_t WS_WOUT = 18 * MiB;
constexpr size_t WS_W1 = 22 * MiB;
constexpr size_t WS_W2 = 38 * MiB;
constexpr size_t WS_XF = 56 * MiB;
constexpr size_t WS_MIXO = 120 * MiB;
constexpr size_t WS_YS5 = 184 * MiB;
constexpr size_t WS_GLAS = 200 * MiB;
constexpr size_t WS_PROJ = 216 * MiB;
constexpr size_t WS_QP = 376 * MiB;
constexpr size_t WS_KP = 408 * MiB;
constexpr size_t WS_LH = 440 * MiB;
constexpr size_t WS_CP = 456 * MiB;
constexpr size_t WS_HID = 216 * MiB;
constexpr size_t WS_OP = 472 * MiB;
constexpr size_t WS_END = 504 * MiB;
constexpr int WLDS = 18432;
constexpr int LDS_BYTES = NWAVES * WLDS;
static_assert(LDS_BYTES >= pg8::STAGE_BYTES && LDS_BYTES >= attn_body::ATTN_LDS_BYTES, "lds");

__device__ __forceinline__ float bf2f(unsigned short b) { return __uint_as_float((unsigned)b << 16); }
__device__ __forceinline__ unsigned pk2(float lo, float hi) { return pg8::cvt_pk_bf16(lo, hi); }
__device__ __forceinline__ void unpack8(const u32x4 v, float* f) {
    f[0] = __uint_as_float(v.x << 16); f[1] = __uint_as_float(v.x & 0xffff0000u); f[2] = __uint_as_float(v.y << 16); f[3] = __uint_as_float(v.y & 0xffff0000u);
    f[4] = __uint_as_float(v.z << 16); f[5] = __uint_as_float(v.z & 0xffff0000u); f[6] = __uint_as_float(v.w << 16); f[7] = __uint_as_float(v.w & 0xffff0000u); }
__device__ __forceinline__ u32x4 pack8(const float* f) { u32x4 w; w.x = pk2(f[0], f[1]); w.y = pk2(f[2], f[3]); w.z = pk2(f[4], f[5]); w.w = pk2(f[6], f[7]); return w; }
__device__ __forceinline__ float sigmoidf_(float z) { return 1.f / (1.f + __expf(-z)); }
__device__ __forceinline__ float gelu_tanh(float x) { return x / (1.f + __expf(-1.5957691216057308f * (x + 0.044715f * x * x * x))); }
__device__ __forceinline__ float wave_sum(float v) {
#pragma unroll
    for (int o = 1; o < 64; o <<= 1) v += __shfl_xor(v, o);
    return v; }
#define WSYNC() asm volatile("s_waitcnt lgkmcnt(0)" ::: "memory")

struct Args { const float* in[34]; float* out; unsigned char* ws; };
typedef const float* const __attribute__((address_space(4)))* KIn;

template <bool WINMAP> __device__ __forceinline__ void transpose_item(const float* W, int K, int Nsrc, int Npad, bf16* WT, LAS float* scr, int item, int lane) {
    const int nblk = Npad / 32, kb = item / nblk, nb = item % nblk, k0 = 64 * kb, n0 = 32 * nb;
    const int nd = n0 + (lane & 31); const int ns = WINMAP ? win_src_col(nd) : nd;
#pragma unroll 8
    for (int i = 0; i < 32; ++i) { const int kk = 2 * i + (lane >> 5); scr[kk * 33 + (lane & 31)] = (ns >= 0) ? W[(size_t)(k0 + kk) * Nsrc + ns] : 0.f; }
    WSYNC();
    const int c = lane & 7;
#pragma unroll
    for (int j = 0; j < 4; ++j) { const int n = (lane >> 3) + 8 * j; const LAS float* s = scr + (8 * c) * 33 + n;
        u32x4 o; o.x = pk2(s[0 * 33], s[1 * 33]); o.y = pk2(s[2 * 33], s[3 * 33]); o.z = pk2(s[4 * 33], s[5 * 33]); o.w = pk2(s[6 * 33], s[7 * 33]);
        *(u32x4*)(WT + (size_t)(n0 + n) * K + k0 + 8 * c) = o; }
    WSYNC();
}
__device__ __forceinline__ void row_norm_to_bf16(const f32x4 (&v)[4], const float* g, bf16* orow, int lane) {
    float s = 0.f;
#pragma unroll
    for (int j = 0; j < 4; ++j) s += (v[j].x * v[j].x + v[j].y * v[j].y) + (v[j].z * v[j].z + v[j].w * v[j].w);
    const float rstd = rsqrtf(wave_sum(s) * (1.f / DM) + EPS);
#pragma unroll
    for (int j = 0; j < 4; ++j) { const f32x4 gg = *(const f32x4*)(g + 256 * j + 4 * lane);
        u32x2 w; w.x = pk2(v[j].x * rstd * gg.x, v[j].y * rstd * gg.y); w.y = pk2(v[j].z * rstd * gg.z, v[j].w * rstd * gg.w);
        *(u32x2*)(orow + 256 * j + 4 * lane) = w; }
}
__device__ __forceinline__ void phase_norm(const float* x, const float* g, bf16* XN, int gw, int NGW, int lane) {
    for (int m = gw; m < T; m += NGW) { f32x4 v[4];
#pragma unroll
        for (int j = 0; j < 4; ++j) v[j] = *(const f32x4*)(x + (size_t)m * DM + 256 * j + 4 * lane);
        row_norm_to_bf16(v, g, XN + (size_t)m * DM, lane); }
}
__device__ __forceinline__ void phase_res_norm(const float* xsrc, float* xdst, const bf16* Fb, const float* gpost, const float* gnext, bf16* XN, int gw, int NGW, int lane) {
    for (int m = gw; m < T; m += NGW) { f32x4 f[4], v[4]; float s = 0.f;
#pragma unroll
        for (int j = 0; j < 4; ++j) { const u32x2 w = *(const u32x2*)(Fb + (size_t)m * DM + 256 * j + 4 * lane);
            f[j].x = __uint_as_float(w.x << 16); f[j].y = __uint_as_float(w.x & 0xffff0000u); f[j].z = __uint_as_float(w.y << 16); f[j].w = __uint_as_float(w.y & 0xffff0000u);
            s += (f[j].x * f[j].x + f[j].y * f[j].y) + (f[j].z * f[j].z + f[j].w * f[j].w);
            v[j] = *(const f32x4*)(xsrc + (size_t)m * DM + 256 * j + 4 * lane); }
        const float rstd = rsqrtf(wave_sum(s) * (1.f / DM) + EPS);
#pragma unroll
        for (int j = 0; j < 4; ++j) { const f32x4 gg = *(const f32x4*)(gpost + 256 * j + 4 * lane);
            v[j].x += f[j].x * rstd * gg.x; v[j].y += f[j].y * rstd * gg.y; v[j].z += f[j].z * rstd * gg.z; v[j].w += f[j].w * rstd * gg.w;
            *(f32x4*)(xdst + (size_t)m * DM + 256 * j + 4 * lane) = v[j]; }
        if (gnext) row_norm_to_bf16(v, gnext, XN + (size_t)m * DM, lane); }
}
__device__ __forceinline__ void phase_rope(const bf16* proj, const float* tab, bf16* QP, bf16* KP, int gid, int gsz) {
    for (int idx = gid; idx < T * 32; idx += gsz) {
        const int row = idx >> 5, r = idx & 31, qk = r >> 4, hp = (r >> 1) & 7, d0 = (r & 1) * 8, pos = row & (SEQ - 1);
        const bf16* src = proj + (size_t)row * PP + (qk ? C_DK : C_DQ) + hp * 32 + d0;
        float x1[8], x2[8], o1[8], o2[8]; unpack8(*(const u32x4*)src, x1); unpack8(*(const u32x4*)(src + 16), x2);
        const float* tp = tab + pos * 32 + d0; const float sc = qk ? 1.f : attn_body::C2;
        const f32x4 c0 = *(const f32x4*)tp, c1 = *(const f32x4*)(tp + 4), s0 = *(const f32x4*)(tp + 16), s1 = *(const f32x4*)(tp + 20);
        const float cs[8] = {c0.x, c0.y, c0.z, c0.w, c1.x, c1.y, c1.z, c1.w}, sn[8] = {s0.x, s0.y, s0.z, s0.w, s1.x, s1.y, s1.z, s1.w};
#pragma unroll
        for (int i = 0; i < 8; ++i) { o1[i] = (x1[i] * cs[i] - x2[i] * sn[i]) * sc; o2[i] = (x2[i] * cs[i] + x1[i] * sn[i]) * sc; }
        bf16* dst = (qk ? KP : QP) + (size_t)row * 512 + hp * 64 + d0;
        *(u32x4*)dst = pack8(o1); *(u32x4*)(dst + 16) = pack8(o2);
        }
}
__device__ __forceinline__ void gla_gates(const bf16* prow, const float* wg, const float* bg, int h, int lane, float (&bc)[32], LAS float* Wst) {
#pragma unroll
    for (int r = 0; r < 8; ++r) { const int i = r * 64 + lane; Wst[i] = wg[(i >> 5) * 128 + h * 32 + (i & 31)]; }
    if (lane < 32) Wst[512 + lane] = bg[h * 32 + lane];
    float glr[16]; unpack8(*(const u32x4*)(prow + C_GLR), glr); unpack8(*(const u32x4*)(prow + C_GLR + 8), glr + 8);
    WSYNC();
#pragma unroll
    for (int d4 = 0; d4 < 8; ++d4) { f32x4 z = *(const LAS f32x4*)(Wst + 512 + 4 * d4);
#pragma unroll
        for (int r = 0; r < 16; ++r) { const f32x4 w = *(const LAS f32x4*)(Wst + r * 32 + 4 * d4); z += w * glr[r]; }
#pragma unroll
        for (int e = 0; e < 4; ++e) bc[4 * d4 + e] = (fminf(z[e], 0.f) - log1pf(__expf(-fabsf(z[e])))) * (1.f / 16.f); }
    WSYNC();
#pragma unroll
    for (int d = 0; d < 32; ++d) { float v = bc[d];
#pragma unroll
        for (int off = 1; off < 64; off <<= 1) { const float t = __shfl_up(v, off); if (lane >= off) v += t; }
        bc[d] = v; }
}
__device__ __forceinline__ void gla_local_unit(int u, const bf16* proj, const float* wg, const float* bg, float* KV, float* DEC, LAS unsigned char* wl, int lane) {
    const int b = u >> 8, h = (u >> 6) & 3, n = u & 63; const size_t row = (size_t)b * SEQ + n * 64 + lane; const bf16* prow = proj + row * PP;
    LAS float* A = (LAS float*)wl; LAS bf16* Bv = (LAS bf16*)(wl + 9216);
    float bc[32]; gla_gates(prow, wg, bg, h, lane, bc, (LAS float*)(wl + 9216));
    float k[32];
#pragma unroll
    for (int i = 0; i < 4; ++i) unpack8(*(const u32x4*)(prow + C_GK + h * 32 + 8 * i), k + 8 * i);
#pragma unroll
    for (int d4 = 0; d4 < 8; ++d4) { f32x4 w;
#pragma unroll
        for (int e = 0; e < 4; ++e) { const int d = 4 * d4 + e; const float bl = __shfl(bc[d], 63); w[e] = k[d] * __expf(bl - bc[d]); }
        *(LAS f32x4*)(A + lane * 36 + 4 * d4) = w; }
#pragma unroll
    for (int i = 0; i < 8; ++i) *(LAS u32x4*)(Bv + lane * 64 + 8 * i) = *(const u32x4*)(prow + C_GV + h * 64 + 8 * i);
    WSYNC();
    float acc[32];
#pragma unroll
    for (int d = 0; d < 32; ++d) acc[d] = 0.f;
    for (int j = 0; j < 64; ++j) { const float vv = bf2f(Bv[j * 64 + lane]);
#pragma unroll
        for (int d4 = 0; d4 < 8; ++d4) { const f32x4 k4 = *(const LAS f32x4*)(A + j * 36 + 4 * d4);
#pragma unroll
            for (int e = 0; e < 4; ++e) acc[4 * d4 + e] += k4[e] * vv; } }
#pragma unroll
    for (int d = 0; d < 32; ++d) KV[((size_t)u * 32 + d) * 64 + lane] = acc[d];
    if (lane == 63) {
#pragma unroll
        for (int d = 0; d < 32; ++d) DEC[u * 32 + d] = __expf(bc[d]); }
    WSYNC();
}
__device__ __forceinline__ void gla_out_unit(int u, const bf16* proj, const float* wg, const float* bg, const float* gn, const float* SP, bf16* MIXO, LAS unsigned char* wl, int lane) {
    const int b = u >> 8, h = (u >> 6) & 3, n = u & 63; const size_t row = (size_t)b * SEQ + n * 64 + lane; const bf16* prow = proj + row * PP;
    LAS float* A = (LAS float*)wl; LAS bf16* Bv = (LAS bf16*)(wl + 9216);
    float bc[32]; gla_gates(prow, wg, bg, h, lane, bc, (LAS float*)(wl + 9216));
    float qd[32];
    { float k[32], q[32];
#pragma unroll
      for (int i = 0; i < 4; ++i) { unpack8(*(const u32x4*)(prow + C_GK + h * 32 + 8 * i), k + 8 * i); unpack8(*(const u32x4*)(prow + C_GQ + h * 32 + 8 * i), q + 8 * i); }
#pragma unroll
      for (int d4 = 0; d4 < 8; ++d4) { f32x4 w;
#pragma unroll
          for (int e = 0; e < 4; ++e) { const int d = 4 * d4 + e; const float ex = __expf(bc[d]); qd[d] = q[d] * 0.17677669529663687f * ex; w[e] = k[d] * __expf(-bc[d]); }
          *(LAS f32x4*)(A + lane * 36 + 4 * d4) = w; } }
#pragma unroll
    for (int i = 0; i < 8; ++i) *(LAS u32x4*)(Bv + lane * 64 + 8 * i) = *(const u32x4*)(prow + C_GV + h * 64 + 8 * i);
    WSYNC();
    float o[64];
#pragma unroll
    for (int v = 0; v < 64; ++v) o[v] = 0.f;
    for (int i = 0; i < 64; ++i) { float a = 0.f;
#pragma unroll
        for (int d4 = 0; d4 < 8; ++d4) { const f32x4 k4 = *(const LAS f32x4*)(A + i * 36 + 4 * d4);
#pragma unroll
            for (int e = 0; e < 4; ++e) a += qd[4 * d4 + e] * k4[e]; }
        a = (i <= lane) ? a : 0.f;
#pragma unroll
        for (int v8 = 0; v8 < 8; ++v8) { float vv[8]; unpack8(*(const LAS u32x4*)(Bv + i * 64 + 8 * v8), vv);
#pragma unroll
            for (int e = 0; e < 8; ++e) o[8 * v8 + e] += a * vv[e]; } }
    WSYNC();
    const float* sp = SP + (size_t)u * 2048;
#pragma unroll 8
    for (int d = 0; d < 32; ++d) A[d * 64 + lane] = sp[d * 64 + lane];
    WSYNC();
#pragma unroll
    for (int d = 0; d < 32; ++d) {
#pragma unroll
        for (int v4 = 0; v4 < 16; ++v4) { const f32x4 s4 = *(const LAS f32x4*)(A + d * 64 + 4 * v4);
#pragma unroll
            for (int e = 0; e < 4; ++e) o[4 * v4 + e] += qd[d] * s4[e]; } }
    float ss = 0.f;
#pragma unroll
    for (int v = 0; v < 64; ++v) ss += o[v] * o[v];
    const float rstd = rsqrtf(ss * (1.f / 64.f) + EPS);
#pragma unroll
    for (int v8 = 0; v8 < 8; ++v8) { float og[8], w[8]; unpack8(*(const u32x4*)(prow + C_GOG + h * 64 + 8 * v8), og);
#pragma unroll
        for (int e = 0; e < 8; ++e) { const float z = og[e]; w[e] = o[8 * v8 + e] * rstd * gn[8 * v8 + e] * (z * sigmoidf_(z)); }
        *(u32x4*)(MIXO + row * DM + h * 64 + 8 * v8) = pack8(w); }
    WSYNC();
}
struct S5P { float abr, abi; float bbr[16], bbi[16]; };
__device__ __forceinline__ void s5_ab(KIn in, int l, int g, int p, float& abr, float& abi, float& cr, float& ci) {
    const float step = __expf(in[15][l * 16 + g]); const float lr = in[16][(l * 16 + g) * 64 + p], li = in[17][(l * 16 + g) * 64 + p];
    const float mag = expf(lr * step); abr = mag * cosf(li * step); abi = mag * sinf(li * step);
    const float den = lr * lr + li * li, nr = abr - 1.f, ni = abi; cr = (nr * lr + ni * li) / den; ci = (ni * lr - nr * li) / den;
}
__device__ __forceinline__ void s5_params(KIn in, int l, int g, int p, S5P& P) {
    float cr, ci; s5_ab(in, l, g, p, P.abr, P.abi, cr, ci);
    const float* br = in[18] + ((size_t)(l * 16 + g) * 64 + p) * 16; const float* bi = in[19] + ((size_t)(l * 16 + g) * 64 + p) * 16;
#pragma unroll
    for (int h4 = 0; h4 < 4; ++h4) { const f32x4 r = *(const f32x4*)(br + 4 * h4), i = *(const f32x4*)(bi + 4 * h4);
#pragma unroll
        for (int e = 0; e < 4; ++e) { P.bbr[4 * h4 + e] = cr * r[e] - ci * i[e]; P.bbi[4 * h4 + e] = cr * i[e] + ci * r[e]; } }
}
__device__ __forceinline__ void s5_step(const S5P& P, const LAS float* urow, float& xr, float& xi) {
    float br = 0.f, bi = 0.f;
#pragma unroll
    for (int h4 = 0; h4 < 4; ++h4) { const f32x4 u4 = *(const LAS f32x4*)(urow + 4 * h4);
#pragma unroll
        for (int e = 0; e < 4; ++e) { br += P.bbr[4 * h4 + e] * u4[e]; bi += P.bbi[4 * h4 + e] * u4[e]; } }
    const float nr = P.abr * xr - P.abi * xi + br, ni = P.abr * xi + P.abi * xr + bi; xr = nr; xi = ni;
}
__device__ __forceinline__ void s5_local_unit(int u, int l, KIn in, const bf16* proj, float* E, LAS unsigned char* wl, int lane) {
    const int b = u >> 8, g = (u >> 4) & 15, c = u & 15; const size_t r0 = (size_t)b * SEQ + c * 256;
    LAS float* U = (LAS float*)wl;
    S5P P; s5_params(in, l, g, lane, P);
#pragma unroll
    for (int it = 0; it < 8; ++it) { const int tok = it * 32 + (lane >> 1), hf = lane & 1; float f[8];
        unpack8(*(const u32x4*)(proj + (r0 + tok) * PP + C_SU + g * 16 + hf * 8), f);
        *(LAS f32x4*)(U + tok * 16 + hf * 8) = (f32x4){f[0], f[1], f[2], f[3]}; *(LAS f32x4*)(U + tok * 16 + hf * 8 + 4) = (f32x4){f[4], f[5], f[6], f[7]}; }
    WSYNC();
    float xr = 0.f, xi = 0.f;
#pragma unroll 4
    for (int t = 0; t < 256; ++t) s5_step(P, U + t * 16, xr, xi);
    E[((size_t)u * 64 + lane) * 2] = xr; E[((size_t)u * 64 + lane) * 2 + 1] = xi;
    WSYNC();
}
__device__ __forceinline__ void s5_out_unit(int u, int l, KIn in, const bf16* proj, const float* E, bf16* YS, LAS unsigned char* wl, int lane) {
    const int b = u >> 8, g = (u >> 4) & 15, c = u & 15; const size_t r0 = (size_t)b * SEQ + c * 256;
    LAS float* XR = (LAS float*)wl; LAS float* XI = XR + 16 * 68; LAS float* U = XI + 16 * 68; LAS float* Cm = U + 256;
    S5P P; s5_params(in, l, g, lane, P);
    { const float* cre = in[20] + (size_t)(l * 16 + g) * 1024; const float* cim = in[21] + (size_t)(l * 16 + g) * 1024;
#pragma unroll 4
      for (int q = 0; q < 16; ++q) { Cm[lane * 32 + q] = cre[q * 64 + lane]; Cm[lane * 32 + 16 + q] = cim[q * 64 + lane]; } }
    float xr = 0.f, xi = 0.f;
    { float ar = P.abr, ai = P.abi;
#pragma unroll
      for (int s = 0; s < 8; ++s) { const float nr = ar * ar - ai * ai, ni = 2.f * ar * ai; ar = nr; ai = ni; }
      for (int cc = 0; cc < c; ++cc) { const size_t idx = ((size_t)(u - c + cc) * 64 + lane) * 2; const float er = E[idx], ei = E[idx + 1];
          const float nr = ar * xr - ai * xi + er, ni = ar * xi + ai * xr + ei; xr = nr; xi = ni; } }
    const int t = lane & 15, qq = lane >> 4;
    const f32x4 dv = *(const f32x4*)(in[22] + l * 256 + g * 16 + qq * 4);
    for (int tt = 0; tt < 16; ++tt) {
        if (lane < 32) { const int tok = lane >> 1, hf = lane & 1; float f[8];
            unpack8(*(const u32x4*)(proj + (r0 + tt * 16 + tok) * PP + C_SU + g * 16 + hf * 8), f);
            *(LAS f32x4*)(U + tok * 16 + hf * 8) = (f32x4){f[0], f[1], f[2], f[3]}; *(LAS f32x4*)(U + tok * 16 + hf * 8 + 4) = (f32x4){f[4], f[5], f[6], f[7]}; }
        WSYNC();
#pragma unroll 4
        for (int s = 0; s < 16; ++s) { s5_step(P, U + s * 16, xr, xi); XR[s * 68 + lane] = xr; XI[s * 68 + lane] = xi; }
        WSYNC();
        f32x4 y = {0.f, 0.f, 0.f, 0.f};
#pragma unroll 4
        for (int p4 = 0; p4 < 16; ++p4) { const f32x4 a = *(const LAS f32x4*)(XR + t * 68 + 4 * p4), bb = *(const LAS f32x4*)(XI + t * 68 + 4 * p4);
#pragma unroll
            for (int e = 0; e < 4; ++e) { const f32x4 cr4 = *(const LAS f32x4*)(Cm + (4 * p4 + e) * 32 + qq * 4), ci4 = *(const LAS f32x4*)(Cm + (4 * p4 + e) * 32 + 16 + qq * 4);
                y += cr4 * a[e] - ci4 * bb[e]; } }
        const f32x4 uu = *(const LAS f32x4*)(U + t * 16 + qq * 4);
        y += dv * uu;
        u32x2 w; w.x = pk2(gelu_tanh(y.x), gelu_tanh(y.y)); w.y = pk2(gelu_tanh(y.z), gelu_tanh(y.w));
        *(u32x2*)(YS + (r0 + tt * 16 + t) * 256 + g * 16 + qq * 4) = w;
        WSYNC();
    }
}
__device__ __forceinline__ void lru_local_unit(int u, int l, KIn in, const bf16* proj, float* PR, float* EN, bf16* LH, bf16* CP, LAS unsigned char* wl, int lane) {
    const int b = u >> 8, n = (u >> 6) & 3, c = u & 63, col = n * 64 + lane; const size_t r0 = (size_t)b * SEQ + c * 64;
    LAS float* XC = (LAS float*)wl;
    const float* cw = in[25] + l * 1024; const float cw0 = cw[col], cw1 = cw[256 + col], cw2 = cw[512 + col], cw3 = cw[768 + col], cb = in[26][l * 256 + col];
    const bf16* xp = proj + r0 * PP + C_RX + col;
    float xm3 = 0.f, xm2 = 0.f, xm1 = 0.f;
    if (c > 0) { xm3 = bf2f(*(xp - 3 * PP)); xm2 = bf2f(*(xp - 2 * PP)); xm1 = bf2f(*(xp - PP)); }
#pragma unroll 8
    for (int t = 0; t < 64; ++t) { const float xt = bf2f(xp[(size_t)t * PP]); XC[t * 64 + lane] = cb + cw0 * xm3 + cw1 * xm2 + cw2 * xm1 + cw3 * xt; xm3 = xm2; xm2 = xm1; xm1 = xt; }
    float wa[64], wx[64];
    { const float* pa = in[27] + (size_t)(l * 4 + n) * 4096 + lane; const float* px = in[29] + (size_t)(l * 4 + n) * 4096 + lane;
#pragma unroll
      for (int k = 0; k < 64; ++k) { wa[k] = pa[k * 64]; wx[k] = px[k * 64]; } }
    const float ba = in[28][l * 256 + col], bx = in[30][l * 256 + col];
    const float sp8 = -8.f * log1pf(expf(-in[31][l * 256 + col]));
    WSYNC();
    float h = 0.f, cp = 1.f;
    for (int t = 0; t < 64; ++t) { float ra = ba, ia = bx;
#pragma unroll
        for (int k4 = 0; k4 < 16; ++k4) { const f32x4 x4 = *(const LAS f32x4*)(XC + t * 64 + 4 * k4);
#pragma unroll
            for (int e = 0; e < 4; ++e) { ra += x4[e] * wa[4 * k4 + e]; ia += x4[e] * wx[4 * k4 + e]; } }
        const float own = XC[t * 64 + lane];
        const float r = sigmoidf_(ra), ig = sigmoidf_(ia), la = sp8 * r, a = __expf(la), mult = sqrtf(fmaxf(-expm1f(2.f * la), 1e-12f));
        h = a * h + mult * ig * own; cp *= a;
        LH[(r0 + t) * 256 + col] = (bf16)(pk2(h, 0.f) & 0xffffu); CP[(r0 + t) * 256 + col] = (bf16)(pk2(cp, 0.f) & 0xffffu); }
    PR[(size_t)(b * 64 + c) * 256 + col] = cp; EN[(size_t)(b * 64 + c) * 256 + col] = h;
    WSYNC();
}
__device__ __forceinline__ void phase_carries(float* GLAS, const float* GDEC, const float* LRUP, float* LRUE, int gid, int gsz) {
    for (int e = gid; e < 65536 + 2048; e += gsz) {
        if (e < 65536) { const int bh = e >> 11, dv = e & 2047, d = dv >> 6; float S = 0.f;
            for (int n = 0; n < 64; ++n) { const size_t idx = ((size_t)(bh * 64 + n)) * 2048 + dv; const float kv = GLAS[idx], dc = GDEC[(bh * 64 + n) * 32 + d]; GLAS[idx] = S; S = dc * S + kv; }
        } else { const int q = e - 65536, b = q >> 8, col = q & 255; float H = 0.f;
            for (int c = 0; c < 64; ++c) { const size_t idx = (size_t)(b * 64 + c) * 256 + col; const float p = LRUP[idx], en = LRUE[idx]; LRUE[idx] = H; H = p * H + en; } }
    }
}
__device__ __forceinline__ void phase_lru_out(const bf16* proj, const bf16* LH, const bf16* CP, const float* HIN, bf16* MIXO, int gid, int gsz) {
    for (int idx = gid; idx < T * 32; idx += gsz) { const int row = idx >> 5, c8 = (idx & 31) * 8, b = row >> 12, ch = (row & (SEQ - 1)) >> 6;
        float lh[8], cp[8], gt[8], o[8]; unpack8(*(const u32x4*)(LH + (size_t)row * 256 + c8), lh); unpack8(*(const u32x4*)(CP + (size_t)row * 256 + c8), cp);
        unpack8(*(const u32x4*)(proj + (size_t)row * PP + C_RG + c8), gt);
        const float* hp = HIN + (size_t)(b * 64 + ch) * 256 + c8; const f32x4 h0 = *(const f32x4*)hp, h1 = *(const f32x4*)(hp + 4);
        const float hin[8] = {h0.x, h0.y, h0.z, h0.w, h1.x, h1.y, h1.z, h1.w};
#pragma unroll
        for (int e = 0; e < 8; ++e) o[e] = (lh[e] + cp[e] * hin[e]) * gelu_tanh(gt[e]);
        *(u32x4*)(MIXO + (size_t)row * DM + 768 + c8) = pack8(o); }
}
__device__ __forceinline__ void phase_diff_out(int l, KIn in, const bf16* OP, bf16* MIXO, int gid, int gsz) {
    float s1 = 0.f, s2 = 0.f;
    for (int i = 0; i < 32; ++i) { s1 += in[10][l * 32 + i] * in[11][l * 32 + i]; s2 += in[12][l * 32 + i] * in[13][l * 32 + i]; }
    const float lam_init = 0.8f - 0.6f * expf(-0.3f * (float)l), lam = expf(s1) - expf(s2) + lam_init, osc = 1.f - lam_init;
    const float* dn = in[14] + l * 64;
    for (int idx = gid; idx < T * 32; idx += gsz) { const int row = idx >> 5, h = (idx >> 3) & 3, v8 = (idx & 7) * 8;
        float a[8], bq[8], o[8]; unpack8(*(const u32x4*)(OP + (size_t)row * 512 + (2 * h) * 64 + v8), a); unpack8(*(const u32x4*)(OP + (size_t)row * 512 + (2 * h + 1) * 64 + v8), bq);
        float ss = 0.f;
#pragma unroll
        for (int e = 0; e < 8; ++e) { o[e] = a[e] - lam * bq[e]; ss += o[e] * o[e]; }
        ss += __shfl_xor(ss, 1); ss += __shfl_xor(ss, 2); ss += __shfl_xor(ss, 4);
        const float rstd = rsqrtf(ss * (1.f / 64.f) + EPS) * osc;
#pragma unroll
        for (int e = 0; e < 8; ++e) o[e] = o[e] * rstd * dn[v8 + e];
        *(u32x4*)(MIXO + (size_t)row * DM + 256 + h * 64 + v8) = pack8(o); }
}

__device__ __forceinline__ void phase_glu_gate(const bf16* YS, const bf16* ZG, const float* bias, bf16* MIXO, int gid, int gsz) {
    for (int idx = gid; idx < T * 32; idx += gsz) { const int row = idx >> 5, c8 = (idx & 31) * 8;
        float y[8], z[8], o[8]; unpack8(*(const u32x4*)(YS + (size_t)row * 256 + c8), y); unpack8(*(const u32x4*)(ZG + (size_t)row * 256 + c8), z);
        const f32x4 b0 = *(const f32x4*)(bias + c8), b1 = *(const f32x4*)(bias + c8 + 4); const float bb[8] = {b0.x, b0.y, b0.z, b0.w, b1.x, b1.y, b1.z, b1.w};
#pragma unroll
        for (int e = 0; e < 8; ++e) o[e] = y[e] * sigmoidf_(z[e] + bb[e]);
        *(u32x4*)(MIXO + (size_t)row * DM + 512 + c8) = pack8(o); }
}

#define XB_TMO      128
#define XB_XCNT(j)  (256  + 64 * (j))
#define XB_XSUB(j)  (1280 + 64 * (j))
#define XB_XGEN(j)  (2304 + 64 * (j))
#define XB_TOP      3328
#define XB_TOPGEN   3392
#define XCD_BAR_WORDS 3456
#define XB_SPIN_CAP (1u << 18)

__device__ __forceinline__ unsigned xb_ld(unsigned* p)              { return __hip_atomic_load(p, __ATOMIC_RELAXED, __HIP_MEMORY_SCOPE_AGENT); }
__device__ __forceinline__ unsigned xb_add(unsigned* p, unsigned v) { return __hip_atomic_fetch_add(p, v, __ATOMIC_RELAXED, __HIP_MEMORY_SCOPE_AGENT); }
__device__ __forceinline__ unsigned xb_xcc_id() { return (unsigned)__builtin_amdgcn_s_getreg((3 << 11) | 20) & 0xFu; }
#define XB_SPIN(cond, bar) do { unsigned _sp = 0; while (cond) { __builtin_amdgcn_s_sleep(1); \
    if ((++_sp & 255u) == 0u) { if (xb_ld(&(bar)[XB_TMO])) break; if (_sp > XB_SPIN_CAP) { atomicAdd(&(bar)[XB_TMO], 1u); break; } } } } while (0)

struct XcdBarrier {
    unsigned* bar; unsigned x;
    volatile LAS unsigned* st;
};

__device__ __forceinline__ XcdBarrier xcd_barrier_post(unsigned* bar, volatile LAS unsigned* st) {
    XcdBarrier b; b.bar = bar; b.x = xb_xcc_id(); b.st = st;
    if (threadIdx.x == 0) (void)xb_add(&bar[XB_XCNT(b.x)], 1u);
    return b;
}
__device__ __forceinline__ void xcd_barrier_complete(unsigned* bar, unsigned x, unsigned& nloc, unsigned& nx) {
    const unsigned G = gridDim.x * gridDim.y * gridDim.z;
    unsigned sum, cnt, mine, sp = 0u;
    for (;;) {
        sum = 0u; cnt = 0u; mine = 0u;
#pragma unroll
        for (unsigned j = 0; j < 16; ++j) { const unsigned c = xb_ld(&bar[XB_XCNT(j)]); sum += c; cnt += (c > 0u) ? 1u : 0u; mine = (j == x) ? c : mine; }
        if (sum == G) break;
        __builtin_amdgcn_s_sleep(1);
        if ((++sp & 255u) == 0u) { if (xb_ld(&bar[XB_TMO])) break; if (sp > XB_SPIN_CAP) { atomicAdd(&bar[XB_TMO], 1u); break; } }
    }
    nloc = mine > 0u ? mine : 1u; nx = cnt > 0u ? cnt : 1u;
}

__device__ __forceinline__ void xcd_barrier(const XcdBarrier& b) {
    asm volatile("s_waitcnt vmcnt(0)" ::: "memory");
    __syncthreads();
    if (threadIdx.x == 0) {
        unsigned* bar = b.bar;
        __builtin_amdgcn_s_waitcnt(0);
        unsigned nloc = b.st[0], nx = b.st[1];
        if (nloc == 0u) { xcd_barrier_complete(bar, b.x, nloc, nx); b.st[0] = nloc; b.st[1] = nx; }
        const unsigned old = xb_add(&bar[XB_XSUB(b.x)], 1u);
        const unsigned gen = old / nloc;
        if (old + 1u == (gen + 1u) * nloc) {
            __builtin_amdgcn_fence(__ATOMIC_RELEASE, "agent");
            asm volatile("s_waitcnt vmcnt(0)" ::: "memory");
            const unsigned og = xb_add(&bar[XB_TOP], 1u);
            const unsigned tg = og / nx;
            if (og + 1u == (tg + 1u) * nx) xb_add(&bar[XB_TOPGEN], 1u);
            else XB_SPIN(xb_ld(&bar[XB_TOPGEN]) == tg, bar);
            __builtin_amdgcn_fence(__ATOMIC_ACQUIRE, "agent");
            xb_add(&bar[XB_XGEN(b.x)], 1u);
            asm volatile("s_waitcnt vmcnt(0)" ::: "memory");
        } else {
            XB_SPIN(xb_ld(&bar[XB_XGEN(b.x)]) == gen, bar);
            __builtin_amdgcn_fence(__ATOMIC_ACQUIRE, "agent");
            asm volatile("s_waitcnt vmcnt(0)" ::: "memory");
        }
    }
    __syncthreads();
}

constexpr size_t WS_CTL = 0;
constexpr int CTL_ZERO_BYTES = 16384;
constexpr int BAR_LDS_OFF = LDS_BYTES;
constexpr int LDS_ALLOC = LDS_BYTES + 256;
#define GRID_BAR() do { XcdBarrier b_; { auto kq_ = __builtin_amdgcn_kernarg_segment_ptr(); asm volatile("" : "+s"(kq_)); b_.bar = (unsigned*)(((KIn)kq_)[35]); } \
    b_.x = xb_xcc_id(); b_.st = (volatile LAS unsigned*)(lds + BAR_LDS_OFF); xcd_barrier(b_); } while (0)
#define PH_BEGIN { int tid_ = threadIdx.x; asm volatile("" : "+v"(tid_)); KIn in; { auto kp_ = __builtin_amdgcn_kernarg_segment_ptr(); asm volatile("" : "+s"(kp_)); in = (KIn)kp_; } \
    float* out = (float*)in[34]; unsigned char* ws = (unsigned char*)in[35]; \
    const int tid = tid_, lane = tid & 63, wave = __builtin_amdgcn_readfirstlane(tid >> 6); int G_ = gridDim.x, bx_ = blockIdx.x; asm volatile("" : "+s"(G_), "+s"(bx_)); const int G = G_, bx = bx_; \
    const int gw = bx * NWAVES + wave, NGW = G * NWAVES, gid = bx * (NWAVES * 64) + tid, gsz = G * NWAVES * 64; LAS unsigned char* wl = lds + wave * WLDS; \
    (void)lane; (void)gw; (void)NGW; (void)gid; (void)gsz; (void)wl; (void)ws; (void)out;
#define PH_END }
#ifndef DUP_MASK
#define DUP_MASK 0
#endif
#define RUN(bit, ...) do { __VA_ARGS__ if (DUP_MASK & (bit)) { __syncthreads(); __VA_ARGS__ } } while (0)
#define WSB(off) ((bf16*)(ws + (off)))
#define WSF(off) ((float*)(ws + (off)))
__global__ void __launch_bounds__(NWAVES * 64) fwd_megakernel(Args args) {
    extern __shared__ __attribute__((aligned(16))) unsigned char lds_raw[];
    cg::grid_group grid = cg::this_grid();
    LAS unsigned char* lds = (LAS unsigned char*)lds_raw;
    if (threadIdx.x < 2) ((volatile LAS unsigned*)(lds + BAR_LDS_OFF))[threadIdx.x] = 0u;
    __syncthreads();
    { auto kq_ = __builtin_amdgcn_kernarg_segment_ptr(); (void)xcd_barrier_post((unsigned*)(((KIn)kq_)[35]), (volatile LAS unsigned*)(lds + BAR_LDS_OFF)); }

    RUN(16, PH_BEGIN
        LAS float* scr = (LAS float*)wl;
        constexpr int I_IN = 16 * 80, I_OUT = 16 * 32, I_1 = 16 * 128, I_2 = 64 * 32, I_G = 4 * 8, I_L = I_IN + I_OUT + I_1 + I_2 + I_G;
        for (int it = gw; it < NLAYER * I_L; it += NGW) { const int l = it / I_L; int r = it % I_L;
            if (r < I_IN) { transpose_item<true>(in[5] + (size_t)l * DM * 2320, DM, 2320, PP, WSB(WS_WIN) + (size_t)l * PP * DM, scr, r, lane); continue; } r -= I_IN;
            if (r < I_OUT) { transpose_item<false>(in[6] + (size_t)l * DM * DM, DM, DM, DM, WSB(WS_WOUT) + (size_t)l * DM * DM, scr, r, lane); continue; } r -= I_OUT;
            if (r < I_1) { transpose_item<false>(in[32] + (size_t)l * DM * DFF, DM, DFF, DFF, WSB(WS_W1) + (size_t)l * DM * DFF, scr, r, lane); continue; } r -= I_1;
            if (r < I_2) { transpose_item<false>(in[33] + (size_t)l * DM * DFF, DFF, DM, DM, WSB(WS_W2) + (size_t)l * DM * DFF, scr, r, lane); continue; } r -= I_2;
            transpose_item<false>(in[23] + (size_t)l * 65536, 256, 256, 256, WSB(WS_WGLU) + (size_t)l * 65536, scr, r, lane); }
        float* ROPE = WSF(WS_ROPE);
        for (int idx = gid; idx < SEQ * 16; idx += gsz) { const int pos = idx >> 4, j = idx & 15; const float inv = powf(10000.f, -(float)j * (1.f / 16.f)); const float ang = (float)pos * inv;
            ROPE[pos * 32 + j] = cosf(ang); ROPE[pos * 32 + 16 + j] = sinf(ang); }
        phase_norm(in[0], in[1], WSB(WS_XF), gw, NGW, lane);
    PH_END);
    grid.sync();
#pragma unroll
    for (int l = 0; l < NLAYER; ++l) {
        RUN(1, PH_BEGIN
          pg8::Gemm g{WSB(WS_XF), WSB(WS_WIN) + (size_t)l * PP * DM, T, PP, DM}; pg8::StaticOrder S; S.init(T, PP, G, bx);
          pg8::EpiBf16<0> E{WSB(WS_PROJ), PP}; pg8::gemm_phase<pg8::EpiBf16<0>, pg8::StaticOrder, true, true>(lds, g, S, E);
        PH_END);
        GRID_BAR();
        RUN(2, PH_BEGIN phase_rope(WSB(WS_PROJ), WSF(WS_ROPE), WSB(WS_QP), WSB(WS_KP), gid, gsz); PH_END);
        RUN(2, PH_BEGIN for (int u = gw; u < 2048; u += NGW) gla_local_unit(u, WSB(WS_PROJ), in[7] + l * 2048, in[8] + l * 128, WSF(WS_GLAS), WSF(WS_GDEC), wl, lane); PH_END);
        RUN(2, PH_BEGIN for (int u = gw; u < 2048; u += NGW) s5_local_unit(u, l, in, WSB(WS_PROJ), WSF(WS_S5E), wl, lane); PH_END);
        RUN(2, PH_BEGIN for (int u = gw; u < 2048; u += NGW) lru_local_unit(u, l, in, WSB(WS_PROJ), WSF(WS_LRUP), WSF(WS_LRUE), WSB(WS_LH), WSB(WS_CP), wl, lane); PH_END);
        GRID_BAR();
        RUN(8, PH_BEGIN for (int u = gw; u < 2048; u += NGW) s5_out_unit(u, l, in, WSB(WS_PROJ), WSF(WS_S5E), WSB(WS_YS5), wl, lane); PH_END);
        RUN(0, PH_BEGIN phase_carries(WSF(WS_GLAS), WSF(WS_GDEC), WSF(WS_LRUP), WSF(WS_LRUE), gid, gsz); PH_END);
        __syncthreads();
        RUN(4, PH_BEGIN
          const attn_body::AttnTensors AT{(const attn_body::bf16*)WSB(WS_QP), (const attn_body::bf16*)WSB(WS_KP), (const attn_body::bf16*)(WSB(WS_PROJ) + C_DV), (attn_body::bf16*)WSB(WS_OP)};
          const attn_body::StaticOrder S(G, bx); attn_body::attn_phase<attn_body::StaticOrder>((char*)lds_raw, AT, S);
        PH_END);
        GRID_BAR();
        RUN(8, PH_BEGIN
          pg8::Gemm g{WSB(WS_YS5), WSB(WS_WGLU) + (size_t)l * 65536, T, 256, 256}; pg8::StaticOrder S; S.init(T, 256, G, bx);
          pg8::EpiBf16<0> E{WSB(WS_KP), 256}; pg8::gemm_phase<pg8::EpiBf16<0>, pg8::StaticOrder, true, true>(lds, g, S, E);
        PH_END);
        RUN(8, PH_BEGIN for (int u = gw; u < 2048; u += NGW) gla_out_unit(u, WSB(WS_PROJ), in[7] + l * 2048, in[8] + l * 128, in[9] + l * 64, WSF(WS_GLAS), WSB(WS_MIXO), wl, lane); PH_END);
        RUN(8, PH_BEGIN phase_lru_out(WSB(WS_PROJ), WSB(WS_LH), WSB(WS_CP), WSF(WS_LRUE), WSB(WS_MIXO), gid, gsz); PH_END);
        RUN(8, PH_BEGIN phase_diff_out(l, in, WSB(WS_OP), WSB(WS_MIXO), gid, gsz); PH_END);
        GRID_BAR();
        RUN(8, PH_BEGIN phase_glu_gate(WSB(WS_YS5), WSB(WS_KP), in[24] + l * 256, WSB(WS_MIXO), gid, gsz); PH_END);
        GRID_BAR();
        RUN(1, PH_BEGIN
          pg8::Gemm g{WSB(WS_MIXO), WSB(WS_WOUT) + (size_t)l * DM * DM, T, DM, DM}; pg8::StaticOrder S; S.init(T, DM, G, bx);
          pg8::EpiBf16<0> E{WSB(WS_XF), DM}; pg8::gemm_phase<pg8::EpiBf16<0>, pg8::StaticOrder, true, true>(lds, g, S, E);
        PH_END);
        GRID_BAR();
        RUN(0, PH_BEGIN phase_res_norm((l == 0) ? in[0] : out, out, WSB(WS_XF), in[2] + l * DM, in[3] + l * DM, WSB(WS_XF), gw, NGW, lane); PH_END);
        GRID_BAR();
        RUN(1, PH_BEGIN
          pg8::Gemm g{WSB(WS_XF), WSB(WS_W1) + (size_t)l * DM * DFF, T, DFF, DM}; pg8::StaticOrder S; S.init(T, DFF, G, bx);
          pg8::EpiBf16<2> E{WSB(WS_HID), DFF}; pg8::gemm_phase<pg8::EpiBf16<2>, pg8::StaticOrder, true, true>(lds, g, S, E);
        PH_END);
        GRID_BAR();
        RUN(1, PH_BEGIN
          pg8::Gemm g{WSB(WS_HID), WSB(WS_W2) + (size_t)l * DM * DFF, T, DM, DFF}; pg8::StaticOrder S; S.init(T, DM, G, bx);
          pg8::EpiBf16<0> E{WSB(WS_XF), DM}; pg8::gemm_phase<pg8::EpiBf16<0>, pg8::StaticOrder, true, true>(lds, g, S, E);
        PH_END);
        GRID_BAR();
        RUN(0, PH_BEGIN phase_res_norm(out, out, WSB(WS_XF), in[4] + l * DM, (l + 1 < NLAYER) ? in[1] + (l + 1) * DM : nullptr, WSB(WS_XF), gw, NGW, lane); PH_END);
        if (l + 1 < NLAYER) GRID_BAR();
    }
    if (DUP_MASK & 32) { for (int i = 0; i < 20; ++i) GRID_BAR(); }
}

extern "C" void kernel_launch(void* const* d_in, const int* in_sizes, int n_in, void* d_out, int out_size, void* d_ws, size_t ws_size, hipStream_t stream) {
    static int grid = 0;
    if (grid == 0) {
        if (n_in != 34 || in_sizes[0] != T * DM || out_size != T * DM || ws_size < WS_END) { fprintf(stderr, "kernel_launch: unexpected shapes (n_in %d in0 %d out %d ws %zu)\n", n_in, n_in > 0 ? in_sizes[0] : -1, out_size, ws_size); grid = -1; return; }
        int dev = 0, cus = 0, per_cu = 0;
        if (hipGetDevice(&dev) != hipSuccess || hipDeviceGetAttribute(&cus, hipDeviceAttributeMultiprocessorCount, dev) != hipSuccess) { grid = -1; return; }
        if (hipFuncSetAttribute((const void*)fwd_megakernel, hipFuncAttributeMaxDynamicSharedMemorySize, LDS_ALLOC) != hipSuccess) { fprintf(stderr, "kernel_launch: hipFuncSetAttribute failed\n"); grid = -1; return; }
        if (hipOccupancyMaxActiveBlocksPerMultiprocessor(&per_cu, (const void*)fwd_megakernel, NWAVES * 64, LDS_ALLOC) != hipSuccess || per_cu < 1) { fprintf(stderr, "kernel_launch: occupancy query says %d\n", per_cu); grid = -1; return; }
        grid = cus;
    }
    if (grid < 0) return;
    if (hipMemsetAsync((char*)d_ws + WS_CTL, 0, CTL_ZERO_BYTES, stream) != hipSuccess) { fprintf(stderr, "kernel_launch: memset failed\n"); return; }
    Args a{};
    for (int i = 0; i < 34; ++i) a.in[i] = (const float*)d_in[i];
    a.out = (float*)d_out; a.ws = (unsigned char*)d_ws;
    void* kargs[] = {&a};
    hipError_t e = hipLaunchCooperativeKernel((const void*)fwd_megakernel, dim3(grid), dim3(NWAVES * 64), kargs, LDS_ALLOC, stream);
    if (e != hipSuccess) fprintf(stderr, "kernel_launch: cooperative launch failed: %s (grid %d)\n", hipGetErrorString(e), grid);
}
```

```cpp
#include <hip/hip_runtime.h>
#include <hip/hip_cooperative_groups.h>
#include <cstdio>
#include <cstdint>
namespace cg = cooperative_groups;
#define DUP_MASK 0
namespace pg8 {
#define PG8_LAS __attribute__((address_space(3)))
typedef unsigned short bf16_t;
typedef short bf16x8 __attribute__((ext_vector_type(8)));
typedef float f32x4 __attribute__((ext_vector_type(4)));
typedef unsigned u32x4 __attribute__((ext_vector_type(4)));
constexpr int BM = 256, BK = 64, HALF = 128, HTB = HALF * BK * 2  , STAGE_BYTES = 8 * HTB, NXCD = 8, WGM = 8;

__host__ __device__ __forceinline__ int lds_byte(int r, int c) { const int st = (r >> 4) * 2 + (c >> 5), rr = r & 15, cc = c & 31, ob = rr * 64 + cc * 2; return st * 1024 + (ob ^ (((ob >> 9) & 1) << 5)); }
__host__ __device__ __forceinline__ void stage_rc(int b, int& R, int& C) { const int st = b / 1024, sb = b % 1024, swz = sb ^ (((sb >> 9) & 1) << 5); R = (st >> 1) * 16 + swz / 64; C = (st & 1) * 32 + (swz % 64) / 2; }
__host__ __device__ __forceinline__ int perm32(int rho) { const int n = rho >> 4, i = rho & 15; return 8 * (i >> 2) + 4 * n + (i & 3); }

struct Unit { int pm, pn; };
struct Gemm { const bf16_t* A; const bf16_t* Bt; int M, N, K; int bgt; size_t bgs; };

struct StaticOrder {
    int nM, nN, nwg, G, c;
    __host__ __device__ void init(int M, int N, int G_, int c_) { nM = M / BM; nN = N / BM; nwg = nM * nN; G = G_; c = c_; }
    __host__ __device__ bool next(int i, Unit& u) const {
        const long L = (long)i * G + c; if (L >= nwg) return false;
        int wgid = (int)L; { const int q = nwg / NXCD, r = nwg % NXCD, xcd = wgid % NXCD, off = wgid / NXCD; wgid = (xcd < r ? xcd * (q + 1) : r * (q + 1) + (xcd - r) * q) + off; }
        const int nig = WGM * nN, gid = wgid / nig, fm = gid * WGM, gsz = (nM - fm) < WGM ? (nM - fm) : WGM;
        u.pm = fm + ((wgid % nig) % gsz); u.pn = (wgid % nig) / gsz; return true;
    }
    __device__ __forceinline__ void a_ready(const Unit&) const {}
    __device__ __forceinline__ void done(const Unit&) const {}
};

__device__ __forceinline__ unsigned cvt_pk_bf16(float lo, float hi) { unsigned r; asm volatile("v_cvt_pk_bf16_f32 %0, %1, %2" : "=v"(r) : "v"(lo), "v"(hi)); return r; }
template <int ACT> struct EpiBf16 {
    static constexpr bool PERM = true, AFTER_DRAIN = false;
    bf16_t* O; int ldc;
    __device__ __forceinline__ void operator()(const f32x4 (&acc)[2][2][4][2], const Unit& u, int wr, int wc, int fr, int fq) const {
        const int row0 = u.pm * BM + wr * 64 + fr; const int col0 = u.pn * BM + wc * 32 + 8 * fq;
#pragma unroll
        for (int ai = 0; ai < 2; ++ai)
#pragma unroll
            for (int m = 0; m < 4; ++m) { bf16_t* rowp = O + (size_t)(row0 + ai * HALF + m * 16) * ldc + col0;
#pragma unroll
                for (int bj = 0; bj < 2; ++bj) { f32x4 v0 = acc[ai][bj][m][0], v1 = acc[ai][bj][m][1];
                    if (ACT == 2) {
#pragma unroll
                        for (int e = 0; e < 4; ++e) { float a = v0[e] > 0.f ? v0[e] : 0.f; v0[e] = a * a; float b = v1[e] > 0.f ? v1[e] : 0.f; v1[e] = b * b; } }
                    u32x4 w; w.x = cvt_pk_bf16(v0[0], v0[1]); w.y = cvt_pk_bf16(v0[2], v0[3]); w.z = cvt_pk_bf16(v1[0], v1[1]); w.w = cvt_pk_bf16(v1[2], v1[3]);
                    *(u32x4*)(rowp + bj * HALF) = w; } }
    }
    __device__ __forceinline__ void fused(f32x4 (&)[2][2][4][2], const Unit&, int, int, int, int, PG8_LAS unsigned char*, int, int) const {}
};
struct EpiGlu {
    static constexpr bool PERM = true, AFTER_DRAIN = false;
    const bf16_t* Y_; const float* bias_; bf16_t* O; int ldo, coff;
    __device__ __forceinline__ void operator()(const f32x4 (&acc)[2][2][4][2], const Unit& u, int wr, int wc, int fr, int fq) const {
        const int row0 = u.pm * BM + wr * 64 + fr; const int col0 = u.pn * BM + wc * 32 + 8 * fq;
        const float* bias = bias_; const bf16_t* Y = Y_; asm volatile("" : "+s"(bias), "+s"(Y));
#pragma unroll
        for (int ai = 0; ai < 2; ++ai)
#pragma unroll
            for (int m = 0; m < 4; ++m) { const size_t row = (size_t)(row0 + ai * HALF + m * 16);
#pragma unroll
                for (int bj = 0; bj < 2; ++bj) { const int c = col0 + bj * HALF;
                    const f32x4 v0 = acc[ai][bj][m][0], v1 = acc[ai][bj][m][1];
                    const f32x4 b0 = *(const f32x4*)(bias + c), b1 = *(const f32x4*)(bias + c + 4);
                    const u32x4 yv = *(const u32x4*)(Y + row * 256 + c);
                    float y[8], o[8];
                    y[0] = __uint_as_float(yv.x << 16); y[1] = __uint_as_float(yv.x & 0xffff0000u); y[2] = __uint_as_float(yv.y << 16); y[3] = __uint_as_float(yv.y & 0xffff0000u);
                    y[4] = __uint_as_float(yv.z << 16); y[5] = __uint_as_float(yv.z & 0xffff0000u); y[6] = __uint_as_float(yv.w << 16); y[7] = __uint_as_float(yv.w & 0xffff0000u);
#pragma unroll
                    for (int e = 0; e < 4; ++e) { o[e] = y[e] * __builtin_amdgcn_rcpf(1.f + __expf(-(v0[e] + b0[e]))); o[4 + e] = y[4 + e] * __builtin_amdgcn_rcpf(1.f + __expf(-(v1[e] + b1[e]))); }
                    u32x4 w; w.x = cvt_pk_bf16(o[0], o[1]); w.y = cvt_pk_bf16(o[2], o[3]); w.z = cvt_pk_bf16(o[4], o[5]); w.w = cvt_pk_bf16(o[6], o[7]);
                    *(u32x4*)(O + row * ldo + coff + c) = w; }
                asm volatile("" ::: "memory"); }
    }
    __device__ __forceinline__ void fused(f32x4 (&)[2][2][4][2], const Unit&, int, int, int, int, PG8_LAS unsigned char*, int, int) const {}
};
struct EpiS5Y {
    static constexpr bool PERM = true, AFTER_DRAIN = false;
    bf16_t* Y;
    __device__ __forceinline__ void operator()(const f32x4 (&acc)[2][2][4][2], const Unit& u, int wr, int wc, int fr, int fq) const {
        const int row0 = u.pm * BM + wr * 64 + fr; const int col0 = wc * 32 + 8 * fq;
#pragma unroll
        for (int ai = 0; ai < 2; ++ai)
#pragma unroll
            for (int m = 0; m < 4; ++m) { const int row = row0 + ai * HALF + m * 16; const int g = row >> 11, b = (row >> 8) & 7, tb = row & 255;
#pragma unroll
                for (int bj = 0; bj < 2; ++bj) { const int n = col0 + bj * HALF, t = n >> 4, q0 = n & 15;
                    const f32x4 v0 = acc[ai][bj][m][0], v1 = acc[ai][bj][m][1]; float o[8];
#pragma unroll
                    for (int e = 0; e < 4; ++e) { const float x = v0[e], y = v1[e];
                        o[e] = x * __builtin_amdgcn_rcpf(1.f + __expf(-1.5957691216057308f * (x + 0.044715f * x * x * x)));
                        o[4 + e] = y * __builtin_amdgcn_rcpf(1.f + __expf(-1.5957691216057308f * (y + 0.044715f * y * y * y))); }
                    u32x4 w; w.x = cvt_pk_bf16(o[0], o[1]); w.y = cvt_pk_bf16(o[2], o[3]); w.z = cvt_pk_bf16(o[4], o[5]); w.w = cvt_pk_bf16(o[6], o[7]);
                    *(u32x4*)(Y + (size_t)(b * 4096 + tb * 16 + t) * 256 + g * 16 + q0) = w; } }
    }
    __device__ __forceinline__ void fused(f32x4 (&)[2][2][4][2], const Unit&, int, int, int, int, PG8_LAS unsigned char*, int, int) const {}
};
template <class Epi, class Sched, bool ALIGN_EPI = false, bool SP2 = false, bool GRP = false>
__device__ __forceinline__ void gemm_phase(PG8_LAS unsigned char* lds, const Gemm g, const Sched& S, const Epi& E) {
    int tid_l = threadIdx.x; asm volatile("" : "+v"(tid_l));
    const int tid = tid_l, wid = __builtin_amdgcn_readfirstlane(tid >> 6), lane = tid & 63, wr = wid >> 2, wc = wid & 3, fr = lane & 15, fq = lane >> 4;
    int K_l = g.K; asm volatile("" : "+s"(K_l));
    const int K = K_l, nt = K / BK;
    unsigned voffA[2], voffB[2];
#pragma unroll
    for (int i = 0; i < 2; ++i) { int R, C; stage_rc(tid * 16 + i * 8192, R, C); const int Rb = Epi::PERM ? ((R & ~31) + perm32(R & 31)) : R;
        voffA[i] = (unsigned)(R * K + C) * 2u; voffB[i] = (unsigned)(Rb * K + C) * 2u; }
    const size_t kstep = (size_t)(BK * 2);
    const size_t hstep = (size_t)HALF * K * 2;
    const size_t tstep = 2 * hstep;
    const unsigned ldsw = (unsigned)wid * 1024u;
    const int aoff = lds_byte(wr * 64 + fr, fq * 8), boff = lds_byte(wc * 32 + fr, fq * 8);
#define PG8_SA(b, h) (((b) * 2 + (h)) * HTB)
#define PG8_SB(b, h) ((4 + (b) * 2 + (h)) * HTB)
#define PG8_STAGE(bufoff, gbase, voff) do { _Pragma("unroll") for (int _i = 0; _i < 2; ++_i) \
        __builtin_amdgcn_global_load_lds((const unsigned*)((const char*)(gbase) + (voff)[_i]), (PG8_LAS unsigned*)(lds + (bufoff) + ldsw + _i * 8192), 16, 0, 0); } while (0)
#define PG8_LDA(dst, b, h) do { _Pragma("unroll") for (int m = 0; m < 4; ++m) _Pragma("unroll") for (int k = 0; k < 2; ++k) dst[m][k] = *(const PG8_LAS bf16x8*)(lds + PG8_SA(b, h) + aoff + m * 2048 + k * 1024); } while (0)
#define PG8_LDB(dst, b, h) do { _Pragma("unroll") for (int n = 0; n < 2; ++n) _Pragma("unroll") for (int k = 0; k < 2; ++k) dst[n][k] = *(const PG8_LAS bf16x8*)(lds + PG8_SB(b, h) + boff + n * 2048 + k * 1024); } while (0)
#define PG8_MMA(ai, bj, At, Bt) do { __builtin_amdgcn_s_setprio(1); _Pragma("unroll") for (int m = 0; m < 4; ++m) _Pragma("unroll") for (int n = 0; n < 2; ++n) _Pragma("unroll") for (int k = 0; k < 2; ++k) \
        acc[ai][bj][m][n] = __builtin_amdgcn_mfma_f32_16x16x32_bf16(Bt[n][k], At[m][k], acc[ai][bj][m][n], 0, 0, 0); __builtin_amdgcn_s_setprio(0); } while (0)
#define PG8_WAIT_V(n) asm volatile("s_waitcnt vmcnt(" #n ")" ::: "memory")
#define PG8_WAIT_L(n) asm volatile("s_waitcnt lgkmcnt(" #n ")" ::: "memory")
#define PG8_BAR __builtin_amdgcn_s_barrier()
#define PG8_SCHED __builtin_amdgcn_sched_barrier(0)
    Unit cur, nxt; int ui = 0;
    if (!S.next(0, cur)) return;
    f32x4 acc[2][2][4][2];
#pragma unroll
    for (int a = 0; a < 2; ++a)
#pragma unroll
        for (int b = 0; b < 2; ++b)
#pragma unroll
            for (int m = 0; m < 4; ++m)
#pragma unroll
                for (int n = 0; n < 2; ++n) acc[a][b][m][n] = (f32x4){0.f, 0.f, 0.f, 0.f};
    bf16x8 At[4][2], B0[2][2], B1[2][2];
    const char* cA = (const char*)g.A + (size_t)cur.pm * tstep; const char* cB = (const char*)g.Bt + (size_t)cur.pn * tstep + (GRP ? (size_t)(cur.pm >> 3) * g.bgs : (size_t)0);
    S.a_ready(cur);
    if constexpr (SP2) {
        PG8_STAGE(PG8_SB(0, 0), cB, voffB); PG8_STAGE(PG8_SB(0, 1), cB + hstep, voffB); PG8_STAGE(PG8_SA(0, 0), cA, voffA); PG8_STAGE(PG8_SA(0, 1), cA + hstep, voffA);
        if (wr == 1) PG8_BAR;
        PG8_WAIT_V(2); PG8_BAR;
        PG8_STAGE(PG8_SB(1, 0), cB + kstep, voffB); PG8_STAGE(PG8_SA(1, 0), cA + kstep, voffA); PG8_STAGE(PG8_SB(1, 1), cB + hstep + kstep, voffB);
        PG8_WAIT_V(6); PG8_BAR;
    } else {
        PG8_STAGE(PG8_SB(0, 0), cB, voffB); PG8_STAGE(PG8_SA(0, 0), cA, voffA); PG8_STAGE(PG8_SB(0, 1), cB + hstep, voffB); PG8_STAGE(PG8_SA(0, 1), cA + hstep, voffA);
        if (wr == 1) PG8_BAR;
        PG8_WAIT_V(4); PG8_BAR;
        PG8_STAGE(PG8_SB(1, 0), cB + kstep, voffB); PG8_STAGE(PG8_SA(1, 0), cA + kstep, voffA); PG8_STAGE(PG8_SB(1, 1), cB + hstep + kstep, voffB);
        PG8_WAIT_V(6); PG8_BAR;
    }
    for (;;) {
        const bool has_next = S.next(ui + 1, nxt);
        const char* nA = has_next ? (const char*)g.A + (size_t)nxt.pm * tstep : cA; const char* nB = has_next ? (const char*)g.Bt + (size_t)nxt.pn * tstep + (GRP ? (size_t)(nxt.pm >> 3) * g.bgs : (size_t)0) : cB;
        for (int t = 0; t < nt; t += 2) {
            const bool last = (t == nt - 2);
            const char* a1 = cA + (size_t)(t + 1) * kstep;
            const char* a2 = last ? nA : cA + (size_t)(t + 2) * kstep; const char* b2 = last ? nB : cB + (size_t)(t + 2) * kstep;
            const char* a3 = a2 + kstep; const char* b3 = b2 + kstep;
            if (last && has_next) S.a_ready(nxt);
            if constexpr (SP2) {
            PG8_LDB(B0, 0, 0); PG8_LDB(B1, 0, 1); PG8_SCHED; PG8_LDA(At, 0, 0); PG8_STAGE(PG8_SA(1, 1), a1 + hstep, voffA);
            PG8_WAIT_V(8); PG8_WAIT_L(0); PG8_BAR; PG8_MMA(0, 0, At, B0); PG8_MMA(0, 1, At, B1); PG8_BAR; PG8_SCHED;
            PG8_LDA(At, 0, 1); PG8_STAGE(PG8_SB(0, 0), b2, voffB); PG8_STAGE(PG8_SB(0, 1), b2 + hstep, voffB); PG8_STAGE(PG8_SA(0, 0), a2, voffA);
            PG8_WAIT_V(8); PG8_WAIT_L(0); PG8_BAR; PG8_MMA(1, 0, At, B0); PG8_MMA(1, 1, At, B1); PG8_BAR; PG8_SCHED;
            PG8_LDB(B0, 1, 0); PG8_LDB(B1, 1, 1); PG8_SCHED; PG8_LDA(At, 1, 0); PG8_STAGE(PG8_SA(0, 1), a2 + hstep, voffA);
            PG8_WAIT_V(8); PG8_WAIT_L(0); PG8_BAR; PG8_MMA(0, 0, At, B0); PG8_MMA(0, 1, At, B1); PG8_BAR; PG8_SCHED;
            PG8_LDA(At, 1, 1); PG8_STAGE(PG8_SB(1, 0), b3, voffB); PG8_STAGE(PG8_SB(1, 1), b3 + hstep, voffB); PG8_STAGE(PG8_SA(1, 0), a3, voffA);
            PG8_WAIT_V(8); PG8_WAIT_L(0); PG8_BAR; PG8_MMA(1, 0, At, B0); PG8_MMA(1, 1, At, B1); PG8_BAR; PG8_SCHED;
            } else {
            PG8_LDB(B0, 0, 0); PG8_SCHED; PG8_LDA(At, 0, 0); PG8_STAGE(PG8_SA(1, 1), a1 + hstep, voffA);
            PG8_WAIT_L(8); PG8_BAR; PG8_WAIT_L(0); PG8_MMA(0, 0, At, B0); PG8_BAR; PG8_SCHED;
            PG8_LDB(B1, 0, 1); PG8_STAGE(PG8_SB(0, 0), b2, voffB);
            PG8_BAR; PG8_WAIT_L(0); PG8_MMA(0, 1, At, B1); PG8_BAR;
            PG8_LDA(At, 0, 1); PG8_STAGE(PG8_SA(0, 0), a2, voffA);
            PG8_BAR; PG8_WAIT_L(0); PG8_MMA(1, 0, At, B0); PG8_BAR; PG8_SCHED;
            PG8_STAGE(PG8_SB(0, 1), b2 + hstep, voffB);
            PG8_WAIT_V(6); PG8_BAR; PG8_MMA(1, 1, At, B1); PG8_BAR;
            PG8_LDB(B0, 1, 0); PG8_SCHED; PG8_LDA(At, 1, 0); PG8_STAGE(PG8_SA(0, 1), a2 + hstep, voffA);
            PG8_WAIT_L(8); PG8_BAR; PG8_WAIT_L(0); PG8_MMA(0, 0, At, B0); PG8_BAR; PG8_SCHED;
            PG8_LDB(B1, 1, 1); PG8_STAGE(PG8_SB(1, 0), b3, voffB);
            PG8_BAR; PG8_WAIT_L(0); PG8_MMA(0, 1, At, B1); PG8_BAR;
            PG8_LDA(At, 1, 1); PG8_STAGE(PG8_SA(1, 0), a3, voffA);
            PG8_BAR; PG8_WAIT_L(0); PG8_MMA(1, 0, At, B0); PG8_BAR; PG8_SCHED;
            PG8_STAGE(PG8_SB(1, 1), b3 + hstep, voffB);
            PG8_WAIT_V(6); PG8_BAR; PG8_MMA(1, 1, At, B1); PG8_BAR;
            }
        }
        if constexpr (ALIGN_EPI) { if (wr == 0) PG8_BAR; }
        if constexpr (!Epi::AFTER_DRAIN) { E(acc, cur, wr, wc, fr, fq); S.done(cur); }
        if (!has_next) break;
#pragma unroll
        for (int a = 0; a < 2; ++a)
#pragma unroll
            for (int b = 0; b < 2; ++b)
#pragma unroll
                for (int m = 0; m < 4; ++m)
#pragma unroll
                    for (int n = 0; n < 2; ++n) acc[a][b][m][n] = (f32x4){0.f, 0.f, 0.f, 0.f};
        cur = nxt; cA = nA; cB = nB; ++ui;
        if constexpr (ALIGN_EPI) { if (wr == 1) PG8_BAR; }
    }
    PG8_WAIT_V(0);
    if constexpr (!ALIGN_EPI) { if (wr == 0) PG8_BAR; }
    PG8_BAR;
    if constexpr (Epi::AFTER_DRAIN) { E.fused(acc, cur, wr, wc, fr, fq, lds, wid, lane); S.done(cur); }
#undef PG8_SA
#undef PG8_SB
#undef PG8_STAGE
#undef PG8_LDA
#undef PG8_LDB
#undef PG8_MMA
#undef PG8_WAIT_V
#undef PG8_WAIT_L
#undef PG8_BAR
#undef PG8_SCHED
}
}
#include <hip/hip_bf16.h>
#include <cmath>
namespace attn_body {
using bf16=__hip_bfloat16;
using bf16x8=__attribute__((ext_vector_type(8)))short;
using s16x4=__attribute__((ext_vector_type(4)))short;
using f32x16=__attribute__((ext_vector_type(16)))float;
using u32x4=__attribute__((ext_vector_type(4)))unsigned;
constexpr int BATCH=8,NHEAD=8,SEQ=4096,D=64,PQ=512,PV=2560;
constexpr int NW=8,QBLK=32,QB=QBLK*NW,KVBLK=64,NQB=SEQ/QB;
constexpr int ATTN_UNIT_ROWS=QB;
__device__ __forceinline__ int crow(int r,int hi){return (r&3)+8*(r>>2)+4*hi;}
#define SBAR() __builtin_amdgcn_sched_barrier(0)
__device__ __forceinline__ void cmask(f32x16&p0,f32x16&p1,int jb,int qrel,int hi){
  const float NEG=-INFINITY; int kb=64*jb+4*hi;
  #pragma unroll
  for(int r=0;r<16;++r){int kv=kb+(r&3)+8*(r>>2); if(kv>qrel)p0[r]=NEG; if(kv+32>qrel)p1[r]=NEG;}
}

constexpr int NSLOT=3, SLOTB=8192;
constexpr int LDS_K=0, LDS_V=NSLOT*SLOTB, LDS_WS=2*NSLOT*SLOTB, LDS_OST=LDS_WS+NW*64*4, LDS_BYTES=LDS_OST+NW*4096;
constexpr float C2=0.17677669529663687f*1.4426950408889634f;
__device__ __forceinline__ void glds16(const void*gsrc,unsigned lds_dst){unsigned keep;
  asm volatile("s_mov_b32 %0, m0\n\ts_mov_b32 m0, %2\n\ts_nop 0\n\tglobal_load_lds_dwordx4 %1, off\n\ts_mov_b32 m0, %0":"=&s"(keep):"v"(gsrc),"s"(lds_dst):"memory");}
__device__ __forceinline__ float max3f(float a,float b,float c){float r;asm("v_max3_f32 %0, %1, %2, %3":"=v"(r):"v"(a),"v"(b),"v"(c));return r;}
__device__ __forceinline__ float max2f(float a,float b){float r;asm("v_max_f32_e32 %0, %1, %2":"=v"(r):"v"(a),"v"(b));return r;}
__device__ __forceinline__ float fadd_s(float a,float b){float r;asm("v_add_f32_e32 %0, %1, %2":"=v"(r):"v"(a),"v"(b));return r;}
__device__ __forceinline__ float fsub_s(float a,float b){float r;asm("v_sub_f32_e32 %0, %1, %2":"=v"(r):"v"(a),"v"(b));return r;}
typedef float f32x2_t __attribute__((ext_vector_type(2))); typedef __bf16 bf16x2_t __attribute__((ext_vector_type(2)));
__device__ __forceinline__ unsigned cvtpk_s(float lo,float hi){f32x2_t v={lo,hi};bf16x2_t b=__builtin_convertvector(v,bf16x2_t);return __builtin_bit_cast(unsigned,b);}
#define WAIT_BAR(N) asm volatile("s_waitcnt vmcnt(" #N ") lgkmcnt(0)\n\ts_barrier":::"memory")

__device__ __forceinline__ void qkt(f32x16&p0,f32x16&p1,const char*Kslot,const bf16x8*qr,const f32x16&negm,int r32,int hi){
  const char*kb=Kslot+hi*1024+r32*16;
  #pragma unroll
  for(int d0=0;d0<2;++d0){
    const bf16x8 b0=*reinterpret_cast<const bf16x8*>(kb+d0*2048);
    const bf16x8 b1=*reinterpret_cast<const bf16x8*>(kb+d0*2048+512);
    if(d0==0){p0=__builtin_amdgcn_mfma_f32_32x32x16_bf16(b0,qr[0],negm,0,0,0);p1=__builtin_amdgcn_mfma_f32_32x32x16_bf16(b1,qr[0],negm,0,0,0);}
    else{p0=__builtin_amdgcn_mfma_f32_32x32x16_bf16(b0,qr[d0],p0,0,0,0);p1=__builtin_amdgcn_mfma_f32_32x32x16_bf16(b1,qr[d0],p1,0,0,0);}}
}
typedef __attribute__((address_space(3))) const char* lds_cptr;
typedef short v4i16_t __attribute__((ext_vector_type(4)));
__device__ __forceinline__ void kload8(bf16x8*kf,lds_cptr kp){
  kf[0]=*(const __attribute__((address_space(3))) bf16x8*)(kp);      kf[1]=*(const __attribute__((address_space(3))) bf16x8*)(kp+512);
  kf[2]=*(const __attribute__((address_space(3))) bf16x8*)(kp+2048); kf[3]=*(const __attribute__((address_space(3))) bf16x8*)(kp+2560);
}
__device__ __forceinline__ void kload2(bf16x8*kf,lds_cptr kp,int j){ kf[2*j]=*(const __attribute__((address_space(3))) bf16x8*)(kp+j*2048); kf[2*j+1]=*(const __attribute__((address_space(3))) bf16x8*)(kp+j*2048+512); }
__device__ __forceinline__ s16x4 vtr(lds_cptr p){ return __builtin_bit_cast(s16x4,__builtin_amdgcn_ds_read_tr16_b64_v4i16((__attribute__((address_space(3))) v4i16_t*)p)); }
__device__ __forceinline__ float rowmax(const f32x16&p0,const f32x16&p1){
  float a=max3f(p0[0],p0[1],p1[0]),b=max3f(p0[2],p0[3],p1[1]);a=max3f(a,p1[2],p1[3]);
  #pragma unroll
  for(int r=4;r<16;r+=4){a=max3f(a,p0[r],p0[r+1]);b=max3f(b,p0[r+2],p0[r+3]);a=max3f(a,p1[r],p1[r+1]);b=max3f(b,p1[r+2],p1[r+3]);}
  const float m=max2f(a,b);
  auto rr=__builtin_amdgcn_permlane32_swap(__float_as_uint(m),__float_as_uint(m),false,false);
  return max2f(__uint_as_float(rr[0]),__uint_as_float(rr[1]));
}
__device__ __forceinline__ void pv(f32x16*o,int vb,bf16x8 pa0,bf16x8 pa1,bf16x8 pa2,bf16x8 pa3){
  #pragma unroll
  for(int d0=0;d0<2;++d0){s16x4 lo[4],hi[4];
    #pragma unroll
    for(int ks=0;ks<4;++ks){
      asm volatile("ds_read_b64_tr_b16 %0,%1 offset:%c2":"=&v"(lo[ks]):"v"(vb),"i"(d0*4096+ks*1024):"memory");
      asm volatile("ds_read_b64_tr_b16 %0,%1 offset:%c2":"=&v"(hi[ks]):"v"(vb),"i"(d0*4096+ks*1024+512):"memory");}
    asm volatile("s_waitcnt lgkmcnt(0)":::"memory");SBAR();
    #define PK(k) (bf16x8){lo[k][0],lo[k][1],lo[k][2],lo[k][3],hi[k][0],hi[k][1],hi[k][2],hi[k][3]}
    o[d0]=__builtin_amdgcn_mfma_f32_32x32x16_bf16(pa0,PK(0),o[d0],0,0,0);
    o[d0]=__builtin_amdgcn_mfma_f32_32x32x16_bf16(pa1,PK(1),o[d0],0,0,0);
    o[d0]=__builtin_amdgcn_mfma_f32_32x32x16_bf16(pa2,PK(2),o[d0],0,0,0);
    o[d0]=__builtin_amdgcn_mfma_f32_32x32x16_bf16(pa3,PK(3),o[d0],0,0,0);
    #undef PK
  }
}

#ifndef ATTN_STORE16
#define ATTN_STORE16(p,v) (*(u32x4*)(p)=(v))
#endif
template<int THRL> __device__ __forceinline__ void attn_unit(int b,int h,int qb,const bf16*Q,const bf16*__restrict__ K,const bf16*__restrict__ V,bf16*O,char*shm){
  int tid_l=threadIdx.x; asm volatile("":"+v"(tid_l));
  const int tid=tid_l,lane=tid&63,r32=lane&31,hi=lane>>5; const int wid=__builtin_amdgcn_readfirstlane(tid>>6);
  const long rowbase=(long)b*SEQ; const int q0=qb*QB;
  const bf16*Qw=Q+(rowbase+q0+wid*QBLK)*PQ+h*D;
  const bf16*Kh=K+rowbase*PQ+h*D,*Vh=V+rowbase*PV+(h>>1)*D;
  const unsigned lds0=(unsigned)(uintptr_t)shm;
  float*wsf=(float*)(shm+LDS_WS)+wid*64;
  const bf16*ksrc=Kh+(long)lane*PQ+wid*8;
  const bf16*vsrc=Vh+(long)(16*(wid&3)+(lane>>2))*PV+(wid>>2)*32+(lane&3)*8;
  const unsigned kdst=lds0+LDS_K+wid*1024, vdst=lds0+LDS_V+wid*1024;
  #define DMA_K(t,slot) glds16(ksrc+(long)(t)*KVBLK*PQ,(unsigned)__builtin_amdgcn_readfirstlane(kdst+(slot)))
  #define DMA_V(t,slot) glds16(vsrc+(long)(t)*KVBLK*PV,(unsigned)__builtin_amdgcn_readfirstlane(vdst+(slot)))
  const int vb0=(int)(lds0+LDS_V)+((lane>>4)&1)*32+(lane&3)*8+(4*hi+((lane&15)>>2))*64;
  const char*Kbase=shm+LDS_K; bf16x8 kf[8];
  const lds_cptr shm3=(lds_cptr)shm; const lds_cptr kp0=shm3+LDS_K+hi*1024+r32*16; const lds_cptr vp0=shm3+LDS_V+((lane>>4)&1)*32+(lane&3)*8+(4*hi+((lane&15)>>2))*64;
  const int NT=(q0+QB)/KVBLK;
  DMA_K(0,0);DMA_V(0,0);DMA_K(1,SLOTB);
  bf16x8 qr[4];
  #pragma unroll
  for(int d0=0;d0<2;++d0)qr[d0]=*reinterpret_cast<const bf16x8*>(&Qw[(long)r32*PQ+d0*16+hi*8]);
  float mhat=0.f,l_reg=0.f;f32x16 o[2];o[0]=f32x16{};o[1]=f32x16{};f32x16 negm=f32x16{};asm volatile("":"+v"(negm));
  const int qrel=wid*QBLK+r32;
  #define CMASK(P0,P1,t) do{int jb_=(t)-(NT-4); if(jb_>=0)cmask(P0,P1,jb_,qrel,hi);}while(0)
  bool resc=false;
  #define START(P0,P1) do{ const float rm=rowmax(P0,P1); resc=false; \
    { const float dl=rm; mhat=fadd_s(mhat,dl); \
      _Pragma("unroll") for(int r=0;r<16;++r){P0[r]=fsub_s(P0[r],dl);P1[r]=fsub_s(P1[r],dl);} \
      _Pragma("unroll") for(int r=0;r<16;++r)negm[r]=-mhat; asm volatile("":"+v"(negm)); } \
    _Pragma("unroll") for(int r=0;r<16;++r)P0[r]=__builtin_amdgcn_exp2f(P0[r]); }while(0)
  #define RESC() do{ if(resc){ asm volatile("s_waitcnt lgkmcnt(0)":::"memory"); \
      _Pragma("unroll") for(int d_=0;d_<2;++d_) _Pragma("unroll") for(int r=0;r<16;++r)o[d_][r]*=wsf[crow(r,hi)]; } }while(0)
  f32x16 pA0,pA1,pB0,pB1;
  int sl_prev=0,sl_cur=0,sl_next=SLOTB;
  #define ROT() do{sl_prev=sl_cur;sl_cur=sl_next;sl_next=(sl_next==(NSLOT-1)*SLOTB)?0:sl_next+SLOTB;}while(0)
  DMA_K(2,2*SLOTB);
  WAIT_BAR(3);
  qkt(pA0,pA1,Kbase,qr,negm,r32,hi);asm volatile("s_nop 15\n\ts_nop 7":"+v"(pA0),"+v"(pA1));CMASK(pA0,pA1,0);
  START(pA0,pA1);
  _Pragma("unroll") for(int r=0;r<16;++r)pA1[r]=__builtin_amdgcn_exp2f(pA1[r]);
  WAIT_BAR(0);
  DMA_K(3,0);DMA_V(1,SLOTB);
  ROT();
  kload8(kf,kp0+sl_cur);
  WAIT_BAR(2);
  s16x4 vlo[8],vhi[8]; u32x4 pw0,pw1,pw2,pw3;
  #define PKW(P,B) cvtpk_s(P[B],P[B+1])
  #define PAF(k) __builtin_bit_cast(bf16x8,pw##k)
  #define VFR(i) (bf16x8){vlo[i][0],vlo[i][1],vlo[i][2],vlo[i][3],vhi[i][0],vhi[i][1],vhi[i][2],vhi[i][3]}
  #define PIN(x) asm volatile("":"+v"(x))
  #define MX3(a,b,c) __builtin_fmaxf(__builtin_fmaxf((a),(b)),(c))
  #define GAPA(MF,A0,A1,A2,A3,W0,W1,PW) do{ MF; sacc+=A0; sacc+=A1; sacc+=A2; sacc+=A3; PIN(sacc); W0; W1; PIN(PW); SBAR(); }while(0)
  #define EX(v) __builtin_amdgcn_exp2f(v)
  #define GAPB(MF,X,B) do{ MF; X[B]=EX(X[B]); X[B+1]=EX(X[B+1]); X[B+2]=EX(X[B+2]); X[B+3]=EX(X[B+3]); PIN(X); SBAR(); }while(0)
  #define VRD(i) do{ vlo[i]=vtr(vp_+(((i)>>2)*4096+((i)&3)*1024)); vhi[i]=vtr(vp_+(((i)>>2)*4096+((i)&3)*1024+512)); }while(0)
  #define KRD(G,j) do{ if(G){ kload2(kf,kp0+sl_next,j); SBAR(); } }while(0)
  #define STEP(C0,C1,P0,P1,t,GK,GV,GL) do{ SBAR(); \
    const lds_cptr vp_=vp0+sl_prev; \
    VRD(0); SBAR(); float sacc=(P0[0]+P0[1]); \
    GAPA(C0=__builtin_amdgcn_mfma_f32_32x32x16_bf16(kf[0],qr[0],negm,0,0,0), P0[2],P0[3],P0[4],P0[5],     pw0[0]=PKW(P0,0), pw0[1]=PKW(P0,2), pw0); \
    VRD(4); SBAR(); GAPA(C1=__builtin_amdgcn_mfma_f32_32x32x16_bf16(kf[1],qr[0],negm,0,0,0), P0[6],P0[7],P0[8],P0[9],     pw0[2]=PKW(P0,4), pw0[3]=PKW(P0,6), pw0); \
    VRD(1); SBAR(); GAPA(C0=__builtin_amdgcn_mfma_f32_32x32x16_bf16(kf[2],qr[1],C0,0,0,0),   P0[10],P0[11],P0[12],P0[13], pw1[0]=PKW(P0,8), pw1[1]=PKW(P0,10), pw1); \
    VRD(5); SBAR(); GAPA(C1=__builtin_amdgcn_mfma_f32_32x32x16_bf16(kf[3],qr[1],C1,0,0,0),   P0[14],P0[15],P1[0],P1[1],   pw1[2]=PKW(P0,12),pw1[3]=PKW(P0,14), pw1); \
    VRD(2); SBAR(); GAPA((void)0,   P1[2],P1[3],P1[4],P1[5],     pw2[0]=PKW(P1,0), pw2[1]=PKW(P1,2), pw2); \
    VRD(6); SBAR(); GAPA((void)0,   P1[6],P1[7],P1[8],P1[9],     pw2[2]=PKW(P1,4), pw2[3]=PKW(P1,6), pw2); \
    VRD(3); SBAR(); GAPA((void)0,   P1[10],P1[11],P1[12],P1[13], pw3[0]=PKW(P1,8), pw3[1]=PKW(P1,10), pw3); \
    VRD(7); SBAR(); GAPA((void)0,   P1[14],P1[15],0.f,0.f,       pw3[2]=PKW(P1,12),pw3[3]=PKW(P1,14), pw3); \
    l_reg+=sacc; \
    if(GK){DMA_K((t)+3,sl_cur);} if(GV){DMA_V((t)+1,sl_next);} \
    CMASK(C0,C1,t); \
    { float a=MX3(C0[0],C0[1],C1[0]),b=MX3(C0[2],C0[3],C1[1]); a=MX3(a,C1[2],C1[3]); \
      _Pragma("unroll") for(int r=4;r<16;r+=4){a=MX3(a,C0[r],C0[r+1]);b=MX3(b,C0[r+2],C0[r+3]);a=MX3(a,C1[r],C1[r+1]);b=MX3(b,C1[r+2],C1[r+3]);} \
      float rm=__builtin_fmaxf(a,b); { auto rr=__builtin_amdgcn_permlane32_swap(__float_as_uint(rm),__float_as_uint(rm),false,false); rm=__builtin_fmaxf(__uint_as_float(rr[0]),__uint_as_float(rr[1])); } \
      resc=false; \
      if(__builtin_expect(__any(rm>(float)THRL),0)){ const float dl=__builtin_fmaxf(rm,0.f); mhat+=dl; \
        _Pragma("unroll") for(int r=0;r<16;++r){C0[r]-=dl;C1[r]-=dl;} \
        _Pragma("unroll") for(int r=0;r<16;++r)negm[r]=-mhat; asm volatile("":"+v"(negm)); \
        const float f=__builtin_amdgcn_exp2f(-dl); l_reg*=f; if(hi==0)wsf[r32]=f; resc=true; } } \
    SBAR(); \
    GAPB(o[0]=__builtin_amdgcn_mfma_f32_32x32x16_bf16(PAF(0),VFR(0),o[0],0,0,0), C0,0); \
    GAPB(o[1]=__builtin_amdgcn_mfma_f32_32x32x16_bf16(PAF(0),VFR(4),o[1],0,0,0), C0,4); \
    KRD(GL,0); GAPB(o[0]=__builtin_amdgcn_mfma_f32_32x32x16_bf16(PAF(1),VFR(1),o[0],0,0,0), C0,8); \
    KRD(GL,1); GAPB(o[1]=__builtin_amdgcn_mfma_f32_32x32x16_bf16(PAF(1),VFR(5),o[1],0,0,0), C0,12); \
    GAPB(o[0]=__builtin_amdgcn_mfma_f32_32x32x16_bf16(PAF(2),VFR(2),o[0],0,0,0), C1,0); \
    GAPB(o[1]=__builtin_amdgcn_mfma_f32_32x32x16_bf16(PAF(2),VFR(6),o[1],0,0,0), C1,4); \
    GAPB(o[0]=__builtin_amdgcn_mfma_f32_32x32x16_bf16(PAF(3),VFR(3),o[0],0,0,0), C1,8); \
    GAPB(o[1]=__builtin_amdgcn_mfma_f32_32x32x16_bf16(PAF(3),VFR(7),o[1],0,0,0), C1,12); \
    }while(0)
  int t=1;
  #undef CMASK
  #define CMASK(P0,P1,t) do{}while(0)
  for(;t+5<NT;t+=2){
    STEP(pB0,pB1,pA0,pA1,t,true,true,true);     WAIT_BAR(2); RESC(); ROT();
    STEP(pA0,pA1,pB0,pB1,t+1,true,true,true);   WAIT_BAR(2); RESC(); ROT();
  }
  #undef CMASK
  #define CMASK(P0,P1,t) do{int jb_=(t)-(NT-4); if(jb_>=0)cmask(P0,P1,jb_,qrel,hi);}while(0)
  #define ENDW(tt) do{ if((tt)+3<NT){WAIT_BAR(2);} else if((tt)+2<NT){WAIT_BAR(1);} else {WAIT_BAR(0);} }while(0)
  for(;t+1<NT;t+=2){
    STEP(pB0,pB1,pA0,pA1,t,(t+3<NT),(t+1<NT),(t+1<NT));       ENDW(t);   RESC(); ROT();
    STEP(pA0,pA1,pB0,pB1,t+1,(t+4<NT),(t+2<NT),(t+2<NT));     ENDW(t+1); RESC(); ROT();
  }
  STEP(pB0,pB1,pA0,pA1,NT-1,false,false,false); RESC();
  { float sacc=pB0[0]+pB0[1]; _Pragma("unroll") for(int r=2;r<16;++r)sacc+=pB0[r]; _Pragma("unroll") for(int r=0;r<16;++r)sacc+=pB1[r]; l_reg+=sacc;
    pw0=(u32x4){PKW(pB0,0),PKW(pB0,2),PKW(pB0,4),PKW(pB0,6)};pw1=(u32x4){PKW(pB0,8),PKW(pB0,10),PKW(pB0,12),PKW(pB0,14)};pw2=(u32x4){PKW(pB1,0),PKW(pB1,2),PKW(pB1,4),PKW(pB1,6)};pw3=(u32x4){PKW(pB1,8),PKW(pB1,10),PKW(pB1,12),PKW(pB1,14)};
    SBAR(); pv(o,vb0+sl_cur,PAF(0),PAF(1),PAF(2),PAF(3)); }
  #undef PKW
  #undef PAF
  #undef VFR
  #undef PIN
  #undef MX3
  #undef GAPA
  #undef GAPB
  #undef EX
  #undef VRD
  #undef KRD
  #undef STEP
  #undef ENDW
  {auto rr=__builtin_amdgcn_permlane32_swap(__float_as_uint(l_reg),__float_as_uint(l_reg),false,false);l_reg=__uint_as_float(rr[0])+__uint_as_float(rr[1]);}
  if(hi==0)wsf[32+r32]=l_reg;asm volatile("s_waitcnt lgkmcnt(0)":::"memory");
  float rli[16];
  #pragma unroll
  for(int r=0;r<16;++r)rli[r]=__builtin_amdgcn_rcpf(wsf[32+crow(r,hi)]);
  bf16*Ow=O+(rowbase+q0+wid*QBLK)*PQ+h*D;
  { bf16*stg=(bf16*)(shm+LDS_OST)+wid*2048;
    #pragma unroll
    for(int r=0;r<16;++r){const int orow=crow(r,hi);
      #pragma unroll
      for(int d0=0;d0<2;++d0)stg[orow*64+d0*32+r32]=__float2bfloat16(o[d0][r]*rli[r]);}
    asm volatile("s_waitcnt lgkmcnt(0)":::"memory");
    #pragma unroll
    for(int i=0;i<4;++i){const int row=i*8+(lane>>3),ch=lane&7; const u32x4 v=*(const u32x4*)(stg+row*64+ch*8); ATTN_STORE16(Ow+(long)row*PQ+ch*8,v);} }
  asm volatile("s_waitcnt lgkmcnt(0)\n\ts_barrier":::"memory");
  #undef DMA_K
  #undef DMA_V
  #undef CMASK
  #undef START
  #undef RESC
  #undef ROT
}
constexpr int ATTN_LDS_BYTES=LDS_BYTES;
struct AttnTensors { const bf16* Q; const bf16* K; const bf16* V; bf16* O; };
struct AttnUnit { int bh; int qb; };
struct StaticOrder {
  int vcu,G;
  __device__ __forceinline__ explicit StaticOrder(int grid,int block):vcu((grid%8==0)?(block%8)*(grid/8)+block/8:block),G(grid){}
  __device__ __forceinline__ bool next(int i,AttnUnit&u)const{
    if(G==256){ if(i>=4)return false; const int s=vcu&3; u.bh=vcu>>2; u.qb=(i==0)?s:(i==1)?7-s:(i==2)?8+s:15-s; return true; }
    const int L=i*G+vcu; if(L>=BATCH*NHEAD*NQB)return false; u.bh=L/NQB; u.qb=NQB-1-(L%NQB); return true; }
  __device__ __forceinline__ void a_ready(const AttnUnit&)const{}
  __device__ __forceinline__ void done(const AttnUnit&)const{}
};
template<class Sched,int THRL=8> __device__ __forceinline__ void attn_phase(char*lds,const AttnTensors&T,const Sched&S){
  AttnUnit u;
  for(int i=0;S.next(i,u);++i){ S.a_ready(u); attn_unit<THRL>(u.bh/NHEAD,u.bh%NHEAD,u.qb,T.Q,T.K,T.V,T.O,lds); S.done(u); }
}
#undef SBAR
#undef WAIT_BAR
}
#define LAS __attribute__((address_space(3)))
typedef unsigned short bf16;
typedef float f32x4 __attribute__((ext_vector_type(4)));
typedef unsigned u32x4 __attribute__((ext_vector_type(4)));
typedef unsigned u32x2 __attribute__((ext_vector_type(2)));
constexpr int NB = 8, SEQ = 4096, T = NB * SEQ, DM = 1024, DFF = 4096, PP = 2560, NLAYER = 2, NWAVES = 8;
constexpr float EPS = 1e-6f;
constexpr int C_GQ = 0, C_GK = 128, C_GV = 256, C_GOG = 512, C_DQ = 768, C_DK = 1024, C_DV = 1280, C_SU = 1536, C_RX = 1792, C_RG = 2048, C_GLR = 2304;
__host__ __device__ __forceinline__ int win_src_col(int c) { return c < 512 ? c : (c < 2304 ? c + 16 : (c < 2320 ? 512 + (c - 2304) : -1)); }
constexpr size_t MiB = 1u << 20;
constexpr size_t WS_ROPE = 1 * MiB;
constexpr size_t WS_KLAG = 2 * MiB;
constexpr size_t WS_LRUP = 3 * MiB;
constexpr size_t WS_LRUE = WS_LRUP + 512 * 1024;
constexpr size_t WS_GDEC = 4 * MiB;
constexpr size_t WS_WGLU = 5 * MiB;
constexpr size_t WS_W1T = 6 * MiB;
constexpr size_t WS_WIN = 8 * MiB;
constexpr size_t WS_WOUT = 18 * MiB;
constexpr size_t WS_W1 = 22 * MiB;
constexpr size_t WS_W2 = 38 * MiB;
constexpr size_t WS_XF = 56 * MiB;
constexpr size_t WS_MIXO = 120 * MiB;
constexpr size_t WS_YS5 = 184 * MiB;
constexpr size_t WS_GLAS = 200 * MiB;
constexpr size_t WS_PROJ = 216 * MiB;
constexpr size_t WS_QP = 376 * MiB;
constexpr size_t WS_KP = 408 * MiB;
constexpr size_t WS_LH = 440 * MiB;
constexpr size_t WS_CP = 456 * MiB;
constexpr size_t WS_HID = 216 * MiB;
constexpr size_t WS_OP = 472 * MiB;
constexpr size_t WS_WY = 504 * MiB;
constexpr size_t WS_END = 510 * MiB;
constexpr size_t WS_UB = WS_XF;
constexpr size_t WS_XU = WS_XF + 16 * MiB;
constexpr size_t WS_SE = WS_XF + 40 * MiB;
constexpr int WLDS = 18432;
constexpr int LDS_BYTES = NWAVES * WLDS;
static_assert(LDS_BYTES >= pg8::STAGE_BYTES && LDS_BYTES >= attn_body::ATTN_LDS_BYTES, "lds");

__device__ __forceinline__ float bf2f(unsigned short b) { return __uint_as_float((unsigned)b << 16); }
__device__ __forceinline__ unsigned pk2(float lo, float hi) { return pg8::cvt_pk_bf16(lo, hi); }
__device__ __forceinline__ void unpack8(const u32x4 v, float* f) {
    f[0] = __uint_as_float(v.x << 16); f[1] = __uint_as_float(v.x & 0xffff0000u); f[2] = __uint_as_float(v.y << 16); f[3] = __uint_as_float(v.y & 0xffff0000u);
    f[4] = __uint_as_float(v.z << 16); f[5] = __uint_as_float(v.z & 0xffff0000u); f[6] = __uint_as_float(v.w << 16); f[7] = __uint_as_float(v.w & 0xffff0000u); }
__device__ __forceinline__ u32x4 pack8(const float* f) { u32x4 w; w.x = pk2(f[0], f[1]); w.y = pk2(f[2], f[3]); w.z = pk2(f[4], f[5]); w.w = pk2(f[6], f[7]); return w; }
__device__ __forceinline__ float sigmoidf_(float z) { return 1.f / (1.f + __expf(-z)); }
__device__ __forceinline__ float gelu_tanh(float x) { return x / (1.f + __expf(-1.5957691216057308f * (x + 0.044715f * x * x * x))); }
__device__ __forceinline__ float wave_sum(float v) {
#pragma unroll
    for (int o = 1; o < 64; o <<= 1) v += __shfl_xor(v, o);
    return v; }
#define WSYNC() asm volatile("s_waitcnt lgkmcnt(0)" ::: "memory")

struct Args { const float* in[34]; float* out; unsigned char* ws; };
typedef const float* const __attribute__((address_space(4)))* KIn;

template <bool WINMAP> __device__ __forceinline__ void transpose_item(const float* W, int K, int Nsrc, int Npad, bf16* WT, LAS float* scr, int item, int lane) {
    const int nblk = Npad / 32, kb = item / nblk, nb = item % nblk, k0 = 64 * kb, n0 = 32 * nb;
    const int nd = n0 + (lane & 31); const int ns = WINMAP ? win_src_col(nd) : nd;
#pragma unroll 8
    for (int i = 0; i < 32; ++i) { const int kk = 2 * i + (lane >> 5); scr[kk * 33 + (lane & 31)] = (ns >= 0) ? W[(size_t)(k0 + kk) * Nsrc + ns] : 0.f; }
    WSYNC();
    const int c = lane & 7;
#pragma unroll
    for (int j = 0; j < 4; ++j) { const int n = (lane >> 3) + 8 * j; const LAS float* s = scr + (8 * c) * 33 + n;
        u32x4 o; o.x = pk2(s[0 * 33], s[1 * 33]); o.y = pk2(s[2 * 33], s[3 * 33]); o.z = pk2(s[4 * 33], s[5 * 33]); o.w = pk2(s[6 * 33], s[7 * 33]);
        *(u32x4*)(WT + (size_t)(n0 + n) * K + k0 + 8 * c) = o; }
    WSYNC();
}
__device__ __forceinline__ void row_norm_to_bf16(const f32x4 (&v)[4], const float* g, bf16* orow, int lane) {
    float s = 0.f;
#pragma unroll
    for (int j = 0; j < 4; ++j) s += (v[j].x * v[j].x + v[j].y * v[j].y) + (v[j].z * v[j].z + v[j].w * v[j].w);
    const float rstd = rsqrtf(wave_sum(s) * (1.f / DM) + EPS);
#pragma unroll
    for (int j = 0; j < 4; ++j) { const f32x4 gg = *(const f32x4*)(g + 256 * j + 4 * lane);
        u32x2 w; w.x = pk2(v[j].x * rstd * gg.x, v[j].y * rstd * gg.y); w.y = pk2(v[j].z * rstd * gg.z, v[j].w * rstd * gg.w);
        *(u32x2*)(orow + 256 * j + 4 * lane) = w; }
}
__device__ __forceinline__ void phase_norm(const float* x, const float* g, bf16* XN, int gw, int NGW, int lane) {
    for (int m = gw; m < T; m += NGW) { f32x4 v[4];
#pragma unroll
        for (int j = 0; j < 4; ++j) v[j] = *(const f32x4*)(x + (size_t)m * DM + 256 * j + 4 * lane);
        row_norm_to_bf16(v, g, XN + (size_t)m * DM, lane); }
}
__device__ __forceinline__ void phase_res_norm(const float* xsrc, float* xdst, const bf16* Fb, const float* gpost, const float* gnext, bf16* XN, int gw, int NGW, int lane) {
    for (int m = gw; m < T; m += NGW) { f32x4 f[4], v[4]; float s = 0.f;
#pragma unroll
        for (int j = 0; j < 4; ++j) { const u32x2 w = *(const u32x2*)(Fb + (size_t)m * DM + 256 * j + 4 * lane);
            f[j].x = __uint_as_float(w.x << 16); f[j].y = __uint_as_float(w.x & 0xffff0000u); f[j].z = __uint_as_float(w.y << 16); f[j].w = __uint_as_float(w.y & 0xffff0000u);
            s += (f[j].x * f[j].x + f[j].y * f[j].y) + (f[j].z * f[j].z + f[j].w * f[j].w);
            v[j] = *(const f32x4*)(xsrc + (size_t)m * DM + 256 * j + 4 * lane); }
        const float rstd = rsqrtf(wave_sum(s) * (1.f / DM) + EPS);
#pragma unroll
        for (int j = 0; j < 4; ++j) { const f32x4 gg = *(const f32x4*)(gpost + 256 * j + 4 * lane);
            v[j].x += f[j].x * rstd * gg.x; v[j].y += f[j].y * rstd * gg.y; v[j].z += f[j].z * rstd * gg.z; v[j].w += f[j].w * rstd * gg.w;
            *(f32x4*)(xdst + (size_t)m * DM + 256 * j + 4 * lane) = v[j]; }
        if (gnext) row_norm_to_bf16(v, gnext, XN + (size_t)m * DM, lane); }
}
__device__ __forceinline__ void phase_rope(const bf16* proj, const float* tab, bf16* QP, bf16* KP, int gid, int gsz) {
    for (int idx = gid; idx < T * 32; idx += gsz) {
        const int row = idx >> 5, r = idx & 31, qk = r >> 4, hp = (r >> 1) & 7, d0 = (r & 1) * 8, pos = row & (SEQ - 1);
        const bf16* src = proj + (size_t)row * PP + (qk ? C_DK : C_DQ) + hp * 32 + d0;
        float x1[8], x2[8], o1[8], o2[8]; unpack8(*(const u32x4*)src, x1); unpack8(*(const u32x4*)(src + 16), x2);
        const float* tp = tab + pos * 32 + d0; const float sc = qk ? 1.f : attn_body::C2;
        const f32x4 c0 = *(const f32x4*)tp, c1 = *(const f32x4*)(tp + 4), s0 = *(const f32x4*)(tp + 16), s1 = *(const f32x4*)(tp + 20);
        const float cs[8] = {c0.x, c0.y, c0.z, c0.w, c1.x, c1.y, c1.z, c1.w}, sn[8] = {s0.x, s0.y, s0.z, s0.w, s1.x, s1.y, s1.z, s1.w};
#pragma unroll
        for (int i = 0; i < 8; ++i) { o1[i] = (x1[i] * cs[i] - x2[i] * sn[i]) * sc; o2[i] = (x2[i] * cs[i] + x1[i] * sn[i]) * sc; }
        bf16* dst = (qk ? KP : QP) + (size_t)row * 512 + hp * 64 + d0;
        *(u32x4*)dst = pack8(o1); *(u32x4*)(dst + 16) = pack8(o2);
        }
}
__device__ __forceinline__ void gla_gates(const bf16* prow, const float* wg, const float* bg, int h, int lane, float (&bc)[32], LAS float* Wst) {
#pragma unroll
    for (int r = 0; r < 8; ++r) { const int i = r * 64 + lane; Wst[i] = wg[(i >> 5) * 128 + h * 32 + (i & 31)]; }
    if (lane < 32) Wst[512 + lane] = bg[h * 32 + lane];
    float glr[16]; unpack8(*(const u32x4*)(prow + C_GLR), glr); unpack8(*(const u32x4*)(prow + C_GLR + 8), glr + 8);
    WSYNC();
#pragma unroll
    for (int d4 = 0; d4 < 8; ++d4) { f32x4 z = *(const LAS f32x4*)(Wst + 512 + 4 * d4);
#pragma unroll
        for (int r = 0; r < 16; ++r) { const f32x4 w = *(const LAS f32x4*)(Wst + r * 32 + 4 * d4); z += w * glr[r]; }
#pragma unroll
        for (int e = 0; e < 4; ++e) bc[4 * d4 + e] = (fminf(z[e], 0.f) - log1pf(__expf(-fabsf(z[e])))) * (1.f / 16.f); }
    WSYNC();
#pragma unroll
    for (int d = 0; d < 32; ++d) { float v = bc[d];
#pragma unroll
        for (int off = 1; off < 64; off <<= 1) { const float t = __shfl_up(v, off); if (lane >= off) v += t; }
        bc[d] = v; }
}
__device__ __forceinline__ void gla_local_unit(int u, const bf16* proj, const float* wg, const float* bg, float* KV, float* DEC, LAS unsigned char* wl, int lane) {
    const int b = u >> 8, h = (u >> 6) & 3, n = u & 63; const size_t row = (size_t)b * SEQ + n * 64 + lane; const bf16* prow = proj + row * PP;
    LAS float* A = (LAS float*)wl; LAS bf16* Bv = (LAS bf16*)(wl + 9216);
    float bc[32]; gla_gates(prow, wg, bg, h, lane, bc, (LAS float*)(wl + 9216));
    float k[32];
#pragma unroll
    for (int i = 0; i < 4; ++i) unpack8(*(const u32x4*)(prow + C_GK + h * 32 + 8 * i), k + 8 * i);
#pragma unroll
    for (int d4 = 0; d4 < 8; ++d4) { f32x4 w;
#pragma unroll
        for (int e = 0; e < 4; ++e) { const int d = 4 * d4 + e; const float bl = __shfl(bc[d], 63); w[e] = k[d] * __expf(bl - bc[d]); }
        *(LAS f32x4*)(A + lane * 36 + 4 * d4) = w; }
#pragma unroll
    for (int i = 0; i < 8; ++i) *(LAS u32x4*)(Bv + lane * 64 + 8 * i) = *(const u32x4*)(prow + C_GV + h * 64 + 8 * i);
    WSYNC();
    f32x4 acc[8];
#pragma unroll
    for (int d = 0; d < 8; ++d) acc[d] = (f32x4){0.f, 0.f, 0.f, 0.f};
#pragma unroll 2
    for (int j = 0; j < 64; ++j) { const float vv = bf2f(Bv[j * 64 + lane]);
#pragma unroll
        for (int d4 = 0; d4 < 8; ++d4) { const f32x4 k4 = *(const LAS f32x4*)(A + j * 36 + 4 * d4); acc[d4] += k4 * vv; } }
#pragma unroll
    for (int d = 0; d < 32; ++d) KV[((size_t)u * 32 + d) * 64 + lane] = acc[d >> 2][d & 3];
    if (lane == 63) {
#pragma unroll
        for (int d = 0; d < 32; ++d) DEC[u * 32 + d] = __expf(bc[d]); }
    WSYNC();
}
__device__ __forceinline__ void gla_out_unit(int u, const bf16* proj, const float* wg, const float* bg, const float* gn, const float* SP, bf16* MIXO, LAS unsigned char* wl, int lane) {
    const int b = u >> 8, h = (u >> 6) & 3, n = u & 63; const size_t row = (size_t)b * SEQ + n * 64 + lane; const bf16* prow = proj + row * PP;
    LAS float* A = (LAS float*)wl; LAS bf16* Bv = (LAS bf16*)(wl + 9216);
    float bc[32]; gla_gates(prow, wg, bg, h, lane, bc, (LAS float*)(wl + 9216));
    float qd[32];
    { float k[32], q[32];
#pragma unroll
      for (int i = 0; i < 4; ++i) { unpack8(*(const u32x4*)(prow + C_GK + h * 32 + 8 * i), k + 8 * i); unpack8(*(const u32x4*)(prow + C_GQ + h * 32 + 8 * i), q + 8 * i); }
#pragma unroll
      for (int d4 = 0; d4 < 8; ++d4) { f32x4 w;
#pragma unroll
          for (int e = 0; e < 4; ++e) { const int d = 4 * d4 + e; const float ex = __expf(bc[d]); qd[d] = q[d] * 0.17677669529663687f * ex; w[e] = k[d] * __expf(-bc[d]); }
          *(LAS f32x4*)(A + lane * 36 + 4 * d4) = w; } }
#pragma unroll
    for (int i = 0; i < 8; ++i) *(LAS u32x4*)(Bv + lane * 64 + 8 * i) = *(const u32x4*)(prow + C_GV + h * 64 + 8 * i);
    WSYNC();
    f32x4 o4[16], qd4[8];
#pragma unroll
    for (int v = 0; v < 16; ++v) o4[v] = (f32x4){0.f, 0.f, 0.f, 0.f};
#pragma unroll
    for (int d4 = 0; d4 < 8; ++d4) qd4[d4] = (f32x4){qd[4 * d4], qd[4 * d4 + 1], qd[4 * d4 + 2], qd[4 * d4 + 3]};
#pragma unroll 2
    for (int i = 0; i < 64; ++i) { f32x4 a4 = {0.f, 0.f, 0.f, 0.f};
#pragma unroll
        for (int d4 = 0; d4 < 8; ++d4) { const f32x4 k4 = *(const LAS f32x4*)(A + i * 36 + 4 * d4); a4 += qd4[d4] * k4; }
        float a = (a4.x + a4.y) + (a4.z + a4.w);
        a = (i <= lane) ? a : 0.f;
#pragma unroll
        for (int v8 = 0; v8 < 8; ++v8) { const u32x4 w = *(const LAS u32x4*)(Bv + i * 64 + 8 * v8);
            const f32x4 va = {__uint_as_float(w.x << 16), __uint_as_float(w.x & 0xffff0000u), __uint_as_float(w.y << 16), __uint_as_float(w.y & 0xffff0000u)};
            const f32x4 vb = {__uint_as_float(w.z << 16), __uint_as_float(w.z & 0xffff0000u), __uint_as_float(w.w << 16), __uint_as_float(w.w & 0xffff0000u)};
            o4[2 * v8] += va * a; o4[2 * v8 + 1] += vb * a; } }
    WSYNC();
    const float* sp = SP + (size_t)u * 2048;
#pragma unroll 8
    for (int d = 0; d < 32; ++d) A[d * 64 + lane] = sp[d * 64 + lane];
    WSYNC();
#pragma unroll
    for (int d = 0; d < 32; ++d) {
#pragma unroll
        for (int v4 = 0; v4 < 16; ++v4) { const f32x4 s4 = *(const LAS f32x4*)(A + d * 64 + 4 * v4); o4[v4] += s4 * qd[d]; } }
    float o[64];
#pragma unroll
    for (int v = 0; v < 64; ++v) o[v] = o4[v >> 2][v & 3];
    float ss = 0.f;
#pragma unroll
    for (int v = 0; v < 64; ++v) ss += o[v] * o[v];
    const float rstd = rsqrtf(ss * (1.f / 64.f) + EPS);
#pragma unroll
    for (int v8 = 0; v8 < 8; ++v8) { float og[8], w[8]; unpack8(*(const u32x4*)(prow + C_GOG + h * 64 + 8 * v8), og);
#pragma unroll
        for (int e = 0; e < 8; ++e) { const float z = og[e]; w[e] = o[8 * v8 + e] * rstd * gn[8 * v8 + e] * (z * sigmoidf_(z)); }
        *(u32x4*)(MIXO + row * DM + h * 64 + 8 * v8) = pack8(w); }
    WSYNC();
}
__device__ __forceinline__ void s5_ab(KIn in, int l, int g, int p, float& abr, float& abi, float& cr, float& ci) {
    const float step = expf(in[15][l * 16 + g]); const float lr = in[16][(l * 16 + g) * 64 + p], li = in[17][(l * 16 + g) * 64 + p];
    const float mag = expf(lr * step); abr = mag * cosf(li * step); abi = mag * sinf(li * step);
    const float den = lr * lr + li * li, nr = abr - 1.f, ni = abi; cr = (nr * lr + ni * li) / den; ci = (ni * lr - nr * li) / den;
}
__device__ __forceinline__ void s5_pow(KIn in, int l, int g, int p, float j, float& re, float& im) {
    const float step = expf(in[15][l * 16 + g]); const float lr = in[16][(l * 16 + g) * 64 + p], li = in[17][(l * 16 + g) * 64 + p];
    const float mag = expf(j * lr * step), ang = j * li * step; re = mag * cosf(ang); im = mag * sinf(ang);
}
__device__ __forceinline__ void s5_klag_unit(int w, KIn in, float* KL, int lane) {
    const int l = w >> 8, g = (w >> 4) & 15, j = w & 15;
    float pr, pi, abr, abi, cr, ci; s5_pow(in, l, g, lane, (float)j, pr, pi); s5_ab(in, l, g, lane, abr, abi, cr, ci);
    float mr[16], mi[16];
    const float* br = in[18] + ((size_t)(l * 16 + g) * 64 + lane) * 16; const float* bi = in[19] + ((size_t)(l * 16 + g) * 64 + lane) * 16;
#pragma unroll
    for (int h = 0; h < 16; ++h) { const float bbr = cr * br[h] - ci * bi[h], bbi = cr * bi[h] + ci * br[h]; mr[h] = pr * bbr - pi * bbi; mi[h] = pr * bbi + pi * bbr; }
    const float* cre = in[20] + (size_t)(l * 16 + g) * 1024 + lane; const float* cim = in[21] + (size_t)(l * 16 + g) * 1024 + lane;
    float keep = 0.f;
    for (int q = 0; q < 16; ++q) { const float c_r = cre[q * 64], c_i = cim[q * 64];
#pragma unroll
        for (int h = 0; h < 16; ++h) { const float v = wave_sum(c_r * mr[h] - c_i * mi[h]); if (lane == (q & 3) * 16 + h) keep = v; }
        if ((q & 3) == 3) KL[((size_t)((l * 16 + g) * 16 + j)) * 256 + (q >> 2) * 64 + lane] = keep; }
}
__device__ __forceinline__ void s5_build_weights(KIn in, const float* KL, bf16* W1T, bf16* WY, int gid, int gsz) {
    for (int idx = gid; idx < 2 * 16 * 128 * 32; idx += gsz) { const int l = idx >> 16, g = (idx >> 12) & 15, n = (idx >> 5) & 127, k0 = (idx & 31) * 8, s = k0 >> 4, h0 = k0 & 15, p = n & 63, isim = n >> 6;
        float pr, pi, abr, abi, cr, ci; s5_pow(in, l, g, p, (float)(15 - s), pr, pi); s5_ab(in, l, g, p, abr, abi, cr, ci);
        const float* br = in[18] + ((size_t)(l * 16 + g) * 64 + p) * 16 + h0; const float* bi = in[19] + ((size_t)(l * 16 + g) * 64 + p) * 16 + h0; float o[8];
#pragma unroll
        for (int e = 0; e < 8; ++e) { const float bbr = cr * br[e] - ci * bi[e], bbi = cr * bi[e] + ci * br[e]; o[e] = isim ? (pr * bbi + pi * bbr) : (pr * bbr - pi * bbi); }
        *(u32x4*)(W1T + ((size_t)((l * 16 + g) * 128 + n)) * 256 + k0) = pack8(o); }
    for (int idx = gid; idx < 2 * 16 * 256 * 48; idx += gsz) { const int l = idx / 196608, r = idx % 196608, g = r / 12288, r2 = r % 12288, n = r2 / 48, k0 = (r2 % 48) * 8, t = n >> 4, q = n & 15; float o[8];
        if (k0 < 128) { const int isim = k0 >> 6, p0 = k0 & 63;
#pragma unroll
            for (int e = 0; e < 8; ++e) { float pr, pi; s5_pow(in, l, g, p0 + e, (float)(t + 1), pr, pi);
                const float c_r = in[20][(size_t)(l * 16 + g) * 1024 + q * 64 + p0 + e], c_i = in[21][(size_t)(l * 16 + g) * 1024 + q * 64 + p0 + e];
                o[e] = isim ? -(c_r * pi + c_i * pr) : (c_r * pr - c_i * pi); }
        } else { const int kk = k0 - 128, s = kk >> 4, h0 = kk & 15;
#pragma unroll
            for (int e = 0; e < 8; ++e) { float v = 0.f; if (s <= t) { v = KL[((size_t)((l * 16 + g) * 16 + (t - s))) * 256 + q * 16 + h0 + e]; if (s == t && h0 + e == q) v += in[22][l * 256 + g * 16 + q]; } o[e] = v; } }
        *(u32x4*)(WY + ((size_t)((l * 16 + g) * 256 + n)) * 384 + k0) = pack8(o); }
}
__device__ __forceinline__ void s5_repack(int pm, const bf16* proj, bf16* UB, bf16* XU, int tid) {
    const int g = pm >> 3, b = pm & 7;
#pragma unroll 4
    for (int i = tid; i < 8192; i += NWAVES * 64) { const int tb = i >> 5, s = (i >> 1) & 15, hf = i & 1;
        const u32x4 v = *(const u32x4*)(proj + ((size_t)b * SEQ + tb * 16 + s) * PP + C_SU + g * 16 + hf * 8);
        *(u32x4*)(UB + ((size_t)pm * 256 + tb) * 256 + s * 16 + hf * 8) = v; *(u32x4*)(XU + ((size_t)pm * 256 + tb) * 384 + 128 + s * 16 + hf * 8) = v; }
}
__device__ __forceinline__ void s5_scan(int pm, int l, KIn in, const bf16* SE, bf16* XU, int p) {
    float ar, ai; s5_pow(in, l, pm >> 3, p, 16.f, ar, ai);
    float xr = 0.f, xi = 0.f;
    for (int tb0 = 0; tb0 < 256; tb0 += 16) { float er[16], ei[16];
#pragma unroll
        for (int i = 0; i < 16; ++i) { const bf16* e = SE + ((size_t)pm * 256 + tb0 + i) * 256 + p; er[i] = bf2f(e[0]); ei[i] = bf2f(e[64]); }
#pragma unroll
        for (int i = 0; i < 16; ++i) { bf16* xo = XU + ((size_t)pm * 256 + tb0 + i) * 384 + p; xo[0] = (bf16)(pk2(xr, 0.f) & 0xffffu); xo[64] = (bf16)(pk2(xi, 0.f) & 0xffffu);
            const float nr = ar * xr - ai * xi + er[i], ni = ar * xi + ai * xr + ei[i]; xr = nr; xi = ni; } }
}
__device__ __forceinline__ void lru_local_unit(int u, int l, KIn in, const bf16* proj, float* PR, float* EN, bf16* LH, bf16* CP, LAS unsigned char* wl, int lane) {
    const int b = u >> 8, n = (u >> 6) & 3, c = u & 63, col = n * 64 + lane; const size_t r0 = (size_t)b * SEQ + c * 64;
    LAS float* XC = (LAS float*)wl;
    const float* cw = in[25] + l * 1024; const float cw0 = cw[col], cw1 = cw[256 + col], cw2 = cw[512 + col], cw3 = cw[768 + col], cb = in[26][l * 256 + col];
    const bf16* xp = proj + r0 * PP + C_RX + col;
    float xm3 = 0.f, xm2 = 0.f, xm1 = 0.f;
    if (c > 0) { xm3 = bf2f(*(xp - 3 * PP)); xm2 = bf2f(*(xp - 2 * PP)); xm1 = bf2f(*(xp - PP)); }
#pragma unroll 8
    for (int t = 0; t < 64; ++t) { const float xt = bf2f(xp[(size_t)t * PP]); XC[t * 64 + lane] = cb + cw0 * xm3 + cw1 * xm2 + cw2 * xm1 + cw3 * xt; xm3 = xm2; xm2 = xm1; xm1 = xt; }
    f32x4 wa[16], wx[16];
    { const float* pa = in[27] + (size_t)(l * 4 + n) * 4096 + lane; const float* px = in[29] + (size_t)(l * 4 + n) * 4096 + lane;
#pragma unroll
      for (int k = 0; k < 16; ++k) { wa[k] = (f32x4){pa[(4 * k) * 64], pa[(4 * k + 1) * 64], pa[(4 * k + 2) * 64], pa[(4 * k + 3) * 64]};
          wx[k] = (f32x4){px[(4 * k) * 64], px[(4 * k + 1) * 64], px[(4 * k + 2) * 64], px[(4 * k + 3) * 64]}; } }
    const float ba = in[28][l * 256 + col], bx = in[30][l * 256 + col];
    const float sp8 = -8.f * log1pf(expf(-in[31][l * 256 + col]));
    WSYNC();
    float h = 0.f, cp = 1.f;
    for (int t = 0; t < 64; ++t) { f32x4 ra4 = {0.f, 0.f, 0.f, 0.f}, ia4 = {0.f, 0.f, 0.f, 0.f};
#pragma unroll
        for (int k4 = 0; k4 < 16; ++k4) { const f32x4 x4 = *(const LAS f32x4*)(XC + t * 64 + 4 * k4); ra4 += x4 * wa[k4]; ia4 += x4 * wx[k4]; }
        const float ra = ba + ((ra4.x + ra4.y) + (ra4.z + ra4.w)), ia = bx + ((ia4.x + ia4.y) + (ia4.z + ia4.w));
        const float own = XC[t * 64 + lane];
        const float r = sigmoidf_(ra), ig = sigmoidf_(ia), la = sp8 * r, a = __expf(la), mult = sqrtf(fmaxf(-expm1f(2.f * la), 1e-12f));
        h = a * h + mult * ig * own; cp *= a;
        LH[(r0 + t) * 256 + col] = (bf16)(pk2(h, 0.f) & 0xffffu); CP[(r0 + t) * 256 + col] = (bf16)(pk2(cp, 0.f) & 0xffffu); }
    PR[(size_t)(b * 64 + c) * 256 + col] = cp; EN[(size_t)(b * 64 + c) * 256 + col] = h;
    WSYNC();
}
__device__ __forceinline__ void phase_carries(float* GLAS, const float* GDEC, const float* LRUP, float* LRUE, int gid, int gsz) {
    for (int e = gid; e < 65536 + 2048; e += gsz) {
        if (e < 65536) { const int bh = e >> 11, dv = e & 2047, d = dv >> 6; float S = 0.f;
            for (int n = 0; n < 64; ++n) { const size_t idx = ((size_t)(bh * 64 + n)) * 2048 + dv; const float kv = GLAS[idx], dc = GDEC[(bh * 64 + n) * 32 + d]; GLAS[idx] = S; S = dc * S + kv; }
        } else { const int q = e - 65536, b = q >> 8, col = q & 255; float H = 0.f;
            for (int c = 0; c < 64; ++c) { const size_t idx = (size_t)(b * 64 + c) * 256 + col; const float p = LRUP[idx], en = LRUE[idx]; LRUE[idx] = H; H = p * H + en; } }
    }
}
__device__ __forceinline__ void phase_lru_out(const bf16* proj, const bf16* LH, const bf16* CP, const float* HIN, bf16* MIXO, int gid, int gsz) {
    for (int idx = gid; idx < T * 32; idx += gsz) { const int row = idx >> 5, c8 = (idx & 31) * 8, b = row >> 12, ch = (row & (SEQ - 1)) >> 6;
        float lh[8], cp[8], gt[8], o[8]; unpack8(*(const u32x4*)(LH + (size_t)row * 256 + c8), lh); unpack8(*(const u32x4*)(CP + (size_t)row * 256 + c8), cp);
        unpack8(*(const u32x4*)(proj + (size_t)row * PP + C_RG + c8), gt);
        const float* hp = HIN + (size_t)(b * 64 + ch) * 256 + c8; const f32x4 h0 = *(const f32x4*)hp, h1 = *(const f32x4*)(hp + 4);
        const float hin[8] = {h0.x, h0.y, h0.z, h0.w, h1.x, h1.y, h1.z, h1.w};
#pragma unroll
        for (int e = 0; e < 8; ++e) o[e] = (lh[e] + cp[e] * hin[e]) * gelu_tanh(gt[e]);
        *(u32x4*)(MIXO + (size_t)row * DM + 768 + c8) = pack8(o); }
}
__device__ __forceinline__ void phase_diff_out(int l, KIn in, const bf16* OP, bf16* MIXO, int gid, int gsz) {
    float s1 = 0.f, s2 = 0.f;
    for (int i = 0; i < 32; ++i) { s1 += in[10][l * 32 + i] * in[11][l * 32 + i]; s2 += in[12][l * 32 + i] * in[13][l * 32 + i]; }
    const float lam_init = 0.8f - 0.6f * expf(-0.3f * (float)l), lam = expf(s1) - expf(s2) + lam_init, osc = 1.f - lam_init;
    const float* dn = in[14] + l * 64;
    for (int idx = gid; idx < T * 32; idx += gsz) { const int row = idx >> 5, h = (idx >> 3) & 3, v8 = (idx & 7) * 8;
        float a[8], bq[8], o[8]; unpack8(*(const u32x4*)(OP + (size_t)row * 512 + (2 * h) * 64 + v8), a); unpack8(*(const u32x4*)(OP + (size_t)row * 512 + (2 * h + 1) * 64 + v8), bq);
        float ss = 0.f;
#pragma unroll
        for (int e = 0; e < 8; ++e) { o[e] = a[e] - lam * bq[e]; ss += o[e] * o[e]; }
        ss += __shfl_xor(ss, 1); ss += __shfl_xor(ss, 2); ss += __shfl_xor(ss, 4);
        const float rstd = rsqrtf(ss * (1.f / 64.f) + EPS) * osc;
#pragma unroll
        for (int e = 0; e < 8; ++e) o[e] = o[e] * rstd * dn[v8 + e];
        *(u32x4*)(MIXO + (size_t)row * DM + 256 + h * 64 + v8) = pack8(o); }
}

__device__ __forceinline__ void phase_glu_gate(const bf16* YS, const bf16* ZG, const float* bias, bf16* MIXO, int gid, int gsz) {
    for (int idx = gid; idx < T * 32; idx += gsz) { const int row = idx >> 5, c8 = (idx & 31) * 8;
        float y[8], z[8], o[8]; unpack8(*(const u32x4*)(YS + (size_t)row * 256 + c8), y); unpack8(*(const u32x4*)(ZG + (size_t)row * 256 + c8), z);
        const f32x4 b0 = *(const f32x4*)(bias + c8), b1 = *(const f32x4*)(bias + c8 + 4); const float bb[8] = {b0.x, b0.y, b0.z, b0.w, b1.x, b1.y, b1.z, b1.w};
#pragma unroll
        for (int e = 0; e < 8; ++e) o[e] = y[e] * sigmoidf_(z[e] + bb[e]);
        *(u32x4*)(MIXO + (size_t)row * DM + 512 + c8) = pack8(o); }
}

#define XB_TMO      128
#define XB_XCNT(j)  (256  + 64 * (j))
#define XB_XSUB(j)  (1280 + 64 * (j))
#define XB_XGEN(j)  (2304 + 64 * (j))
#define XB_TOP      3328
#define XB_TOPGEN   3392
#define XCD_BAR_WORDS 3456
#define XB_SPIN_CAP (1u << 18)

__device__ __forceinline__ unsigned xb_ld(unsigned* p)              { return __hip_atomic_load(p, __ATOMIC_RELAXED, __HIP_MEMORY_SCOPE_AGENT); }
__device__ __forceinline__ unsigned xb_add(unsigned* p, unsigned v) { return __hip_atomic_fetch_add(p, v, __ATOMIC_RELAXED, __HIP_MEMORY_SCOPE_AGENT); }
__device__ __forceinline__ unsigned xb_xcc_id() { return (unsigned)__builtin_amdgcn_s_getreg((3 << 11) | 20) & 0xFu; }
#define XB_SPIN(cond, bar) do { unsigned _sp = 0; while (cond) { __builtin_amdgcn_s_sleep(1); \
    if ((++_sp & 255u) == 0u) { if (xb_ld(&(bar)[XB_TMO])) break; if (_sp > XB_SPIN_CAP) { atomicAdd(&(bar)[XB_TMO], 1u); break; } } } } while (0)

struct XcdBarrier {
    unsigned* bar; unsigned x;
    volatile LAS unsigned* st;
};

__device__ __forceinline__ XcdBarrier xcd_barrier_post(unsigned* bar, volatile LAS unsigned* st) {
    XcdBarrier b; b.bar = bar; b.x = xb_xcc_id(); b.st = st;
    if (threadIdx.x == 0) (void)xb_add(&bar[XB_XCNT(b.x)], 1u);
    return b;
}
__device__ __forceinline__ void xcd_barrier_complete(unsigned* bar, unsigned x, unsigned& nloc, unsigned& nx) {
    const unsigned G = gridDim.x * gridDim.y * gridDim.z;
    unsigned sum, cnt, mine, sp = 0u;
    for (;;) {
        sum = 0u; cnt = 0u; mine = 0u;
#pragma unroll
        for (unsigned j = 0; j < 16; ++j) { const unsigned c = xb_ld(&bar[XB_XCNT(j)]); sum += c; cnt += (c > 0u) ? 1u : 0u; mine = (j == x) ? c : mine; }
        if (sum == G) break;
        __builtin_amdgcn_s_sleep(1);
        if ((++sp & 255u) == 0u) { if (xb_ld(&bar[XB_TMO])) break; if (sp > XB_SPIN_CAP) { atomicAdd(&bar[XB_TMO], 1u); break; } }
    }
    nloc = mine > 0u ? mine : 1u; nx = cnt > 0u ? cnt : 1u;
}

__device__ __forceinline__ void xcd_barrier(const XcdBarrier& b) {
    asm volatile("s_waitcnt vmcnt(0)" ::: "memory");
    __syncthreads();
    if (threadIdx.x == 0) {
        unsigned* bar = b.bar;
        __builtin_amdgcn_s_waitcnt(0);
        unsigned nloc = b.st[0], nx = b.st[1];
        if (nloc == 0u) { xcd_barrier_complete(bar, b.x, nloc, nx); b.st[0] = nloc; b.st[1] = nx; }
        const unsigned old = xb_add(&bar[XB_XSUB(b.x)], 1u);
        const unsigned gen = old / nloc;
        if (old + 1u == (gen + 1u) * nloc) {
            __builtin_amdgcn_fence(__ATOMIC_RELEASE, "agent");
            asm volatile("s_waitcnt vmcnt(0)" ::: "memory");
            const unsigned og = xb_add(&bar[XB_TOP], 1u);
            const unsigned tg = og / nx;
            if (og + 1u == (tg + 1u) * nx) xb_add(&bar[XB_TOPGEN], 1u);
            else XB_SPIN(xb_ld(&bar[XB_TOPGEN]) == tg, bar);
            __builtin_amdgcn_fence(__ATOMIC_ACQUIRE, "agent");
            xb_add(&bar[XB_XGEN(b.x)], 1u);
            asm volatile("s_waitcnt vmcnt(0)" ::: "memory");
        } else {
            XB_SPIN(xb_ld(&bar[XB_XGEN(b.x)]) == gen, bar);
            __builtin_amdgcn_fence(__ATOMIC_ACQUIRE, "agent");
            asm volatile("s_waitcnt vmcnt(0)" ::: "memory");
        }
    }
    __syncthreads();
}

constexpr size_t WS_CTL = 0;
constexpr int CTL_ZERO_BYTES = 16384;
constexpr int BAR_LDS_OFF = LDS_BYTES;
constexpr int LDS_ALLOC = LDS_BYTES + 256;
#define GRID_BAR() do { XcdBarrier b_; { auto kq_ = __builtin_amdgcn_kernarg_segment_ptr(); asm volatile("" : "+s"(kq_)); b_.bar = (unsigned*)(((KIn)kq_)[35]); } \
    b_.x = xb_xcc_id(); b_.st = (volatile LAS unsigned*)(lds + BAR_LDS_OFF); xcd_barrier(b_); } while (0)
#define PH_BEGIN { int tid_ = threadIdx.x; asm volatile("" : "+v"(tid_)); KIn in; { auto kp_ = __builtin_amdgcn_kernarg_segment_ptr(); asm volatile("" : "+s"(kp_)); in = (KIn)kp_; } \
    float* out = (float*)in[34]; unsigned char* ws = (unsigned char*)in[35]; \
    const int tid = tid_, lane = tid & 63, wave = __builtin_amdgcn_readfirstlane(tid >> 6); int G_ = gridDim.x, bx_ = blockIdx.x; asm volatile("" : "+s"(G_), "+s"(bx_)); const int G = G_, bx = bx_; \
    const int gw = bx * NWAVES + wave, NGW = G * NWAVES, gid = bx * (NWAVES * 64) + tid, gsz = G * NWAVES * 64; LAS unsigned char* wl = lds + wave * WLDS; \
    (void)lane; (void)gw; (void)NGW; (void)gid; (void)gsz; (void)wl; (void)ws; (void)out;
#define PH_END }
#ifndef DUP_MASK
#define DUP_MASK 0
#endif
#define RUN(bit, ...) do { __VA_ARGS__ if (DUP_MASK & (bit)) { __syncthreads(); __VA_ARGS__ } } while (0)
#define WSB(off) ((bf16*)(ws + (off)))
#define WSF(off) ((float*)(ws + (off)))
__global__ void __launch_bounds__(NWAVES * 64) fwd_megakernel(Args args) {
    extern __shared__ __attribute__((aligned(16))) unsigned char lds_raw[];
    cg::grid_group grid = cg::this_grid();
    LAS unsigned char* lds = (LAS unsigned char*)lds_raw;
    if (threadIdx.x < 2) ((volatile LAS unsigned*)(lds + BAR_LDS_OFF))[threadIdx.x] = 0u;
    __syncthreads();
    { auto kq_ = __builtin_amdgcn_kernarg_segment_ptr(); (void)xcd_barrier_post((unsigned*)(((KIn)kq_)[35]), (volatile LAS unsigned*)(lds + BAR_LDS_OFF)); }

    RUN(16, PH_BEGIN
        LAS float* scr = (LAS float*)wl;
        constexpr int I_IN = 16 * 80, I_OUT = 16 * 32, I_1 = 16 * 128, I_2 = 64 * 32, I_G = 4 * 8, I_L = I_IN + I_OUT + I_1 + I_2 + I_G;
        for (int it = gw; it < NLAYER * I_L; it += NGW) { const int l = it / I_L; int r = it % I_L;
            if (r < I_IN) { transpose_item<true>(in[5] + (size_t)l * DM * 2320, DM, 2320, PP, WSB(WS_WIN) + (size_t)l * PP * DM, scr, r, lane); continue; } r -= I_IN;
            if (r < I_OUT) { transpose_item<false>(in[6] + (size_t)l * DM * DM, DM, DM, DM, WSB(WS_WOUT) + (size_t)l * DM * DM, scr, r, lane); continue; } r -= I_OUT;
            if (r < I_1) { transpose_item<false>(in[32] + (size_t)l * DM * DFF, DM, DFF, DFF, WSB(WS_W1) + (size_t)l * DM * DFF, scr, r, lane); continue; } r -= I_1;
            if (r < I_2) { transpose_item<false>(in[33] + (size_t)l * DM * DFF, DFF, DM, DM, WSB(WS_W2) + (size_t)l * DM * DFF, scr, r, lane); continue; } r -= I_2;
            transpose_item<false>(in[23] + (size_t)l * 65536, 256, 256, 256, WSB(WS_WGLU) + (size_t)l * 65536, scr, r, lane); }
        float* ROPE = WSF(WS_ROPE);
        for (int idx = gid; idx < SEQ * 16; idx += gsz) { const int pos = idx >> 4, j = idx & 15; const float inv = powf(10000.f, -(float)j * (1.f / 16.f)); const float ang = (float)pos * inv;
            ROPE[pos * 32 + j] = cosf(ang); ROPE[pos * 32 + 16 + j] = sinf(ang); }
        phase_norm(in[0], in[1], WSB(WS_XF), gw, NGW, lane);
        for (int w = gw; w < 512; w += NGW) s5_klag_unit(w, in, WSF(WS_KLAG), lane);
    PH_END);
    grid.sync();
    PH_BEGIN s5_build_weights(in, WSF(WS_KLAG), WSB(WS_W1T), WSB(WS_WY), gid, gsz); PH_END
#pragma unroll
    for (int l = 0; l < NLAYER; ++l) {
        RUN(1, PH_BEGIN
          pg8::Gemm g{WSB(WS_XF), WSB(WS_WIN) + (size_t)l * PP * DM, T, PP, DM}; pg8::StaticOrder S; S.init(T, PP, G, bx);
          pg8::EpiBf16<0> E{WSB(WS_PROJ), PP}; pg8::gemm_phase<pg8::EpiBf16<0>, pg8::StaticOrder, true, true>(lds, g, S, E);
        PH_END);
        GRID_BAR();
        RUN(512, PH_BEGIN phase_rope(WSB(WS_PROJ), WSF(WS_ROPE), WSB(WS_QP), WSB(WS_KP), gid, gsz); PH_END);
        RUN(128, PH_BEGIN for (int u = gw; u < 2048; u += NGW) gla_local_unit(u, WSB(WS_PROJ), in[7] + l * 2048, in[8] + l * 128, WSF(WS_GLAS), WSF(WS_GDEC), wl, lane); PH_END);
        RUN(64, PH_BEGIN
          { pg8::StaticOrder S; S.init(T, 256, G, bx); pg8::Unit un; if (S.next(0, un)) s5_repack(un.pm, WSB(WS_PROJ), WSB(WS_UB), WSB(WS_XU), tid); }
          asm volatile("s_waitcnt vmcnt(0)" ::: "memory"); __syncthreads();
        PH_END
        PH_BEGIN
          pg8::Gemm g{WSB(WS_UB), WSB(WS_W1T) + (size_t)l * 16 * 128 * 256, T, 256, 256, 8, (size_t)128 * 256 * 2}; pg8::StaticOrder S; S.init(T, 256, G, bx);
          pg8::EpiBf16<0> E{WSB(WS_SE), 256}; pg8::gemm_phase<pg8::EpiBf16<0>, pg8::StaticOrder, true, true, true>(lds, g, S, E);
          asm volatile("s_waitcnt vmcnt(0)" ::: "memory"); __syncthreads();
        PH_END
        PH_BEGIN
          pg8::StaticOrder S; S.init(T, 256, G, bx); pg8::Unit un;
          if (S.next(0, un) && tid < 64) { __builtin_amdgcn_fence(__ATOMIC_ACQUIRE, "agent"); s5_scan(un.pm, l, in, WSB(WS_SE), WSB(WS_XU), tid); }
        PH_END);
        RUN(256, PH_BEGIN for (int u = gw; u < 2048; u += NGW) lru_local_unit(u, l, in, WSB(WS_PROJ), WSF(WS_LRUP), WSF(WS_LRUE), WSB(WS_LH), WSB(WS_CP), wl, lane); PH_END);
        GRID_BAR();
        RUN(64, PH_BEGIN
          pg8::Gemm g{WSB(WS_XU), WSB(WS_WY) + (size_t)l * 16 * 256 * 384, T, 256, 384, 8, (size_t)256 * 384 * 2}; pg8::StaticOrder S; S.init(T, 256, G, bx);
          pg8::EpiS5Y E{WSB(WS_YS5)}; pg8::gemm_phase<pg8::EpiS5Y, pg8::StaticOrder, true, true, true>(lds, g, S, E);
        PH_END);
        RUN(0, PH_BEGIN phase_carries(WSF(WS_GLAS), WSF(WS_GDEC), WSF(WS_LRUP), WSF(WS_LRUE), gid, gsz); PH_END);
        __syncthreads();
        RUN(4, PH_BEGIN
          const attn_body::AttnTensors AT{(const attn_body::bf16*)WSB(WS_QP), (const attn_body::bf16*)WSB(WS_KP), (const attn_body::bf16*)(WSB(WS_PROJ) + C_DV), (attn_body::bf16*)WSB(WS_OP)};
          const attn_body::StaticOrder S(G, bx); attn_body::attn_phase<attn_body::StaticOrder>((char*)lds_raw, AT, S);
        PH_END);
        GRID_BAR();
        RUN(512, PH_BEGIN
          pg8::Gemm g{WSB(WS_YS5), WSB(WS_WGLU) + (size_t)l * 65536, T, 256, 256}; pg8::StaticOrder S; S.init(T, 256, G, bx);
          pg8::EpiBf16<0> E{WSB(WS_KP), 256}; pg8::gemm_phase<pg8::EpiBf16<0>, pg8::StaticOrder, true, true>(lds, g, S, E);
        PH_END);
        RUN(128, PH_BEGIN for (int u = gw; u < 2048; u += NGW) gla_out_unit(u, WSB(WS_PROJ), in[7] + l * 2048, in[8] + l * 128, in[9] + l * 64, WSF(WS_GLAS), WSB(WS_MIXO), wl, lane); PH_END);
        RUN(256, PH_BEGIN phase_lru_out(WSB(WS_PROJ), WSB(WS_LH), WSB(WS_CP), WSF(WS_LRUE), WSB(WS_MIXO), gid, gsz); PH_END);
        RUN(512, PH_BEGIN phase_diff_out(l, in, WSB(WS_OP), WSB(WS_MIXO), gid, gsz); PH_END);
        GRID_BAR();
        RUN(512, PH_BEGIN phase_glu_gate(WSB(WS_YS5), WSB(WS_KP), in[24] + l * 256, WSB(WS_MIXO), gid, gsz); PH_END);
        GRID_BAR();
        RUN(1, PH_BEGIN
          pg8::Gemm g{WSB(WS_MIXO), WSB(WS_WOUT) + (size_t)l * DM * DM, T, DM, DM}; pg8::StaticOrder S; S.init(T, DM, G, bx);
          pg8::EpiBf16<0> E{WSB(WS_XF), DM}; pg8::gemm_phase<pg8::EpiBf16<0>, pg8::StaticOrder, true, true>(lds, g, S, E);
        PH_END);
        GRID_BAR();
        RUN(0, PH_BEGIN phase_res_norm((l == 0) ? in[0] : out, out, WSB(WS_XF), in[2] + l * DM, in[3] + l * DM, WSB(WS_XF), gw, NGW, lane); PH_END);
        GRID_BAR();
        RUN(1, PH_BEGIN
          pg8::Gemm g{WSB(WS_XF), WSB(WS_W1) + (size_t)l * DM * DFF, T, DFF, DM}; pg8::StaticOrder S; S.init(T, DFF, G, bx);
          pg8::EpiBf16<2> E{WSB(WS_HID), DFF}; pg8::gemm_phase<pg8::EpiBf16<2>, pg8::StaticOrder, true, true>(lds, g, S, E);
        PH_END);
        GRID_BAR();
        RUN(1, PH_BEGIN
          pg8::Gemm g{WSB(WS_HID), WSB(WS_W2) + (size_t)l * DM * DFF, T, DM, DFF}; pg8::StaticOrder S; S.init(T, DM, G, bx);
          pg8::EpiBf16<0> E{WSB(WS_XF), DM}; pg8::gemm_phase<pg8::EpiBf16<0>, pg8::StaticOrder, true, true>(lds, g, S, E);
        PH_END);
        GRID_BAR();
        RUN(0, PH_BEGIN phase_res_norm(out, out, WSB(WS_XF), in[4] + l * DM, (l + 1 < NLAYER) ? in[1] + (l + 1) * DM : nullptr, WSB(WS_XF), gw, NGW, lane); PH_END);
        if (l + 1 < NLAYER) GRID_BAR();
    }
    if (DUP_MASK & 32) { for (int i = 0; i < 20; ++i) GRID_BAR(); }
}

extern "C" void kernel_launch(void* const* d_in, const int* in_sizes, int n_in, void* d_out, int out_size, void* d_ws, size_t ws_size, hipStream_t stream) {
    static int grid = 0;
    if (grid == 0) {
        if (n_in != 34 || in_sizes[0] != T * DM || out_size != T * DM || ws_size < WS_END) { fprintf(stderr, "kernel_launch: unexpected shapes (n_in %d in0 %d out %d ws %zu)\n", n_in, n_in > 0 ? in_sizes[0] : -1, out_size, ws_size); grid = -1; return; }
        int dev = 0, cus = 0, per_cu = 0;
        if (hipGetDevice(&dev) != hipSuccess || hipDeviceGetAttribute(&cus, hipDeviceAttributeMultiprocessorCount, dev) != hipSuccess) { grid = -1; return; }
        if (hipFuncSetAttribute((const void*)fwd_megakernel, hipFuncAttributeMaxDynamicSharedMemorySize, LDS_ALLOC) != hipSuccess) { fprintf(stderr, "kernel_launch: hipFuncSetAttribute failed\n"); grid = -1; return; }
        if (hipOccupancyMaxActiveBlocksPerMultiprocessor(&per_cu, (const void*)fwd_megakernel, NWAVES * 64, LDS_ALLOC) != hipSuccess || per_cu < 1) { fprintf(stderr, "kernel_launch: occupancy query says %d\n", per_cu); grid = -1; return; }
        grid = cus;
    }
    if (grid < 0) return;
    if (hipMemsetAsync((char*)d_ws + WS_CTL, 0, CTL_ZERO_BYTES, stream) != hipSuccess) { fprintf(stderr, "kernel_launch: memset failed\n"); return; }
    Args a{};
    for (int i = 0; i < 34; ++i) a.in[i] = (const float*)d_in[i];
    a.out = (float*)d_out; a.ws = (unsigned char*)d_ws;
    void* kargs[] = {&a};
    hipError_t e = hipLaunchCooperativeKernel((const void*)fwd_megakernel, dim3(grid), dim3(NWAVES * 64), kargs, LDS_ALLOC, stream);
    if (e != hipSuccess) fprintf(stderr, "kernel_launch: cooperative launch failed: %s (grid %d)\n", hipGetErrorString(e), grid);
}
```
